# Optimizing an MI355X kernel written in HIP

```python
import math
import jax, jax.numpy as jnp
from jax import lax
import numpy as np

D_MODEL = 1024
BATCH = 4
SEQ = 8192
DEPTH = 2

N_A_LAYERS = DEPTH // 2
N_B_LAYERS = DEPTH - N_A_LAYERS
D_FF = 2816
RWKV_HEAD = 64
RWKV_HEADS = D_MODEL // RWKV_HEAD
LORA_DECAY = 64
LORA_AAA = 64
LORA_GATE = 160
RWKV_LN_EPS = 64e-5
N_SHIFT_MIX = 6
DIFF_HEAD = 64
DIFF_HEADS = D_MODEL // (2 * DIFF_HEAD)
DIFF_V_HEAD = 2 * DIFF_HEAD
Q_BLOCK = 128
NORM_EPS = 1e-6
SUBLN_EPS = 1e-5

kernel_name = "rwkv7_diffattn_yoco_macaron"


def rms_norm(x, g, eps=NORM_EPS):
    xf = x.astype(jnp.float32)
    y = xf * lax.rsqrt(jnp.mean(xf * xf, axis=-1, keepdims=True) + eps)
    return (y * g.astype(jnp.float32)).astype(x.dtype)


def swiglu(h, w_in, w_out):
    gate, up = jnp.split(h @ w_in, 2, axis=-1)
    return (jax.nn.silu(gate) * up) @ w_out


def lambda_init(layer_idx):
    return 0.8 - 0.6 * math.exp(-0.3 * layer_idx)


def alibi_slopes(n_heads):
    return 2.0 ** (-8.0 * jnp.arange(1, n_heads + 1, dtype=jnp.float32) / n_heads)


def wkv7_scan(r, decay, k, v, a, b):
    B, T, H, N = r.shape

    def step(S, inp):
        r_t, w_t, k_t, v_t, a_t, b_t = inp
        sa = jnp.einsum('bhij,bhj->bhi', S, a_t)
        S = S * w_t[:, :, None, :] + sa[..., None] * b_t[:, :, None, :] + v_t[..., None] * k_t[:, :, None, :]
        return S, jnp.einsum('bhij,bhj->bhi', S, r_t)

    xs = [jnp.moveaxis(t.astype(jnp.float32), 1, 0) for t in (r, decay, k, v, a, b)]
    S0 = jnp.zeros((B, H, N, N), jnp.float32)
    _, y = lax.scan(step, S0, xs)
    return jnp.moveaxis(y, 0, 1)


def rwkv7_time_mix(h, mu, w_rkv, w0, w1, w2, a0, a1, a2, g1, g2, k_k, k_a, r_k, ln_g, ln_b, w_o):
    B, T, C = h.shape
    H, N = RWKV_HEADS, RWKV_HEAD
    h_prev = jnp.pad(h, ((0, 0), (1, 0), (0, 0)))[:, :-1]
    dx = h_prev - h
    r, k, v = jnp.einsum('sbtc,scd->sbtd', h[None] + dx[None] * mu[:3, None, None, :], w_rkv)
    xw = h + dx * mu[3]
    xa = h + dx * mu[4]
    xg = h + dx * mu[5]
    w_log = -jax.nn.softplus(-(w0 + jnp.tanh(xw @ w1) @ w2)) - 0.5
    decay = jnp.exp(-jnp.exp(w_log.astype(jnp.float32)))
    a = jax.nn.sigmoid(a0 + (xa @ a1) @ a2)
    g = jax.nn.sigmoid(xg @ g1) @ g2
    kk = (k * k_k).reshape(B, T, H, N).astype(jnp.float32)
    kk = kk * lax.rsqrt(jnp.maximum(jnp.sum(kk * kk, axis=-1, keepdims=True), 1e-24))
    k = k * (1 + (a - 1) * k_a)
    heads = lambda t: t.reshape(B, T, H, N)
    a_h = heads(a).astype(jnp.float32)
    y = wkv7_scan(heads(r), heads(decay), heads(k), heads(v), -kk, kk * a_h)
    mean = jnp.mean(y, axis=-1, keepdims=True)
    var = jnp.mean(jnp.square(y - mean), axis=-1, keepdims=True)
    y = ((y - mean) * lax.rsqrt(var + RWKV_LN_EPS)).reshape(B, T, C) * ln_g + ln_b
    bonus = jnp.sum(heads(r).astype(jnp.float32) * heads(k).astype(jnp.float32) * r_k, axis=-1, keepdims=True)
    y = y + (bonus * heads(v).astype(jnp.float32)).reshape(B, T, C)
    return (y.astype(h.dtype) * g) @ w_o


def shared_kv(x, kv_norm, w_kv, k_norm):
    B, T, _ = x.shape
    kv = rms_norm(x, kv_norm) @ w_kv
    k = rms_norm(kv[..., :D_MODEL].reshape(B, T, DIFF_HEADS, 2, DIFF_HEAD), k_norm).transpose(0, 2, 3, 1, 4)
    v = kv[..., D_MODEL:].reshape(B, T, DIFF_HEADS, DIFF_V_HEAD).transpose(0, 2, 1, 3)
    return k, v


def diff_attention(h, k_sh, v_sh, w_q, q_norm, lam, subln, w_o, lam_init):
    B, T, _ = h.shape
    H, d = DIFF_HEADS, DIFF_HEAD
    n_blk = T // Q_BLOCK
    q = rms_norm((h @ w_q).reshape(B, T, H, 2, d), q_norm)
    q = q.reshape(B, n_blk, Q_BLOCK, H, 2, d).transpose(1, 0, 3, 4, 2, 5)
    lamf = lam.astype(jnp.float32)
    lam_full = jnp.exp(jnp.sum(lamf[0] * lamf[1])) - jnp.exp(jnp.sum(lamf[2] * lamf[3])) + lam_init
    slopes = alibi_slopes(H)
    k_pos = jnp.arange(T, dtype=jnp.int32)
    scale = d ** -0.5

    def block(args):
        qb, start = args
        s = jnp.einsum('bhcqd,bhckd->bhcqk', qb, k_sh).astype(jnp.float32) * scale
        dist = (start + jnp.arange(Q_BLOCK, dtype=jnp.int32))[:, None] - k_pos[None, :]
        bias = -slopes[:, None, None] * dist.astype(jnp.float32)
        s = jnp.where(dist >= 0, s + bias[None, :, None], -jnp.inf)
        p = jax.nn.softmax(s, axis=-1)
        attn = p[:, :, 0] - lam_full * p[:, :, 1]
        return jnp.einsum('bhqk,bhkd->bhqd', attn.astype(v_sh.dtype), v_sh)

    starts = jnp.arange(n_blk, dtype=jnp.int32) * Q_BLOCK
    o = lax.map(block, (q, starts))
    o = rms_norm(o, subln, SUBLN_EPS) * (1.0 - lam_init)
    o = o.transpose(1, 0, 3, 2, 4).reshape(B, T, H * DIFF_V_HEAD)
    return o @ w_o


def setup_inputs(seed: int = 0) -> dict:
    key = jax.random.key(seed)
    ks = jax.random.split(key, 29)
    C, F = D_MODEL, D_FF
    nA, nB = N_A_LAYERS, N_B_LAYERS
    nrm = lambda k, shape, s: jax.random.normal(k, shape, jnp.float32) * s
    gain = lambda k, shape: 1.0 + nrm(k, shape, 0.02)
    return {
        "x": nrm(ks[0], (BATCH, SEQ, C), 1.0),
        "ffn_norm": gain(ks[1], (DEPTH, 2, C)),
        "ffn_w_in": nrm(ks[2], (DEPTH, 2, C, 2 * F), C ** -0.5),
        "ffn_w_out": nrm(ks[3], (DEPTH, 2, F, C), F ** -0.5),
        "mix_norm": gain(ks[4], (DEPTH, C)),
        "rwkv_mu": jax.random.uniform(ks[5], (nA, N_SHIFT_MIX, C), jnp.float32),
        "rwkv_w_rkv": nrm(ks[6], (nA, 3, C, C), C ** -0.5),
        "rwkv_w0": jax.random.uniform(ks[7], (nA, C), jnp.float32, -6.0, -1.0),
        "rwkv_w1": nrm(ks[8], (nA, C, LORA_DECAY), C ** -0.5),
        "rwkv_w2": nrm(ks[9], (nA, LORA_DECAY, C), 0.5 * LORA_DECAY ** -0.5),
        "rwkv_a0": nrm(ks[10], (nA, C), 0.1),
        "rwkv_a1": nrm(ks[11], (nA, C, LORA_AAA), C ** -0.5),
        "rwkv_a2": nrm(ks[12], (nA, LORA_AAA, C), 0.5 * LORA_AAA ** -0.5),
        "rwkv_g1": nrm(ks[13], (nA, C, LORA_GATE), C ** -0.5),
        "rwkv_g2": nrm(ks[14], (nA, LORA_GATE, C), LORA_GATE ** -0.5),
        "rwkv_k_k": 0.85 + nrm(ks[15], (nA, C), 0.02),
        "rwkv_k_a": gain(ks[16], (nA, C)),
        "rwkv_r_k": nrm(ks[17], (nA, RWKV_HEADS, RWKV_HEAD), 0.1),
        "rwkv_ln_g": gain(ks[18], (nA, C)),
        "rwkv_ln_b": nrm(ks[19], (nA, C), 0.02),
        "rwkv_w_o": nrm(ks[20], (nA, C, C), 0.5 * C ** -0.5),
        "kv_norm": gain(ks[21], (C,)),
        "w_kv": nrm(ks[22], (C, 2 * C), C ** -0.5),
        "k_norm": gain(ks[23], (DIFF_HEAD,)),
        "diff_w_q": nrm(ks[24], (nB, C, C), C ** -0.5),
        "diff_q_norm": gain(ks[25], (nB, DIFF_HEAD)),
        "diff_lambda": nrm(ks[26], (nB, 4, DIFF_HEAD), 0.1),
        "diff_subln": gain(ks[27], (nB, DIFF_V_HEAD)),
        "diff_w_o": nrm(ks[28], (nB, C, C), 0.5 * C ** -0.5),
    }


def reference(x, ffn_norm, ffn_w_in, ffn_w_out, mix_norm, rwkv_mu, rwkv_w_rkv, rwkv_w0, rwkv_w1, rwkv_w2,
              rwkv_a0, rwkv_a1, rwkv_a2, rwkv_g1, rwkv_g2, rwkv_k_k, rwkv_k_a, rwkv_r_k, rwkv_ln_g, rwkv_ln_b,
              rwkv_w_o, kv_norm, w_kv, k_norm, diff_w_q, diff_q_norm, diff_lambda, diff_subln, diff_w_o):
    k_sh = None
    v_sh = None
    for l in range(DEPTH):
        x = x + 0.5 * swiglu(rms_norm(x, ffn_norm[l, 0]), ffn_w_in[l, 0], ffn_w_out[l, 0])
        h = rms_norm(x, mix_norm[l])
        if l < N_A_LAYERS:
            i = l
            x = x + rwkv7_time_mix(h, rwkv_mu[i], rwkv_w_rkv[i], rwkv_w0[i], rwkv_w1[i], rwkv_w2[i],
                                   rwkv_a0[i], rwkv_a1[i], rwkv_a2[i], rwkv_g1[i], rwkv_g2[i],
                                   rwkv_k_k[i], rwkv_k_a[i], rwkv_r_k[i], rwkv_ln_g[i], rwkv_ln_b[i], rwkv_w_o[i])
        else:
            j = l - N_A_LAYERS
            x = x + diff_attention(h, k_sh, v_sh, diff_w_q[j], diff_q_norm[j], diff_lambda[j],
                                   diff_subln[j], diff_w_o[j], lambda_init(l))
        x = x + 0.5 * swiglu(rms_norm(x, ffn_norm[l, 1]), ffn_w_in[l, 1], ffn_w_out[l, 1])
        if l == N_A_LAYERS - 1:
            k_sh, v_sh = shared_kv(x, kv_norm, w_kv, k_norm)
    return x
```

```cpp
#include <hip/hip_runtime.h>
#include <hip/hip_cooperative_groups.h>
#include <cstdio>
#include <cstdint>
namespace cg = cooperative_groups;

namespace pg8 {
#define PG8_LAS __attribute__((address_space(3)))
typedef unsigned short bf16_t;
typedef short bf16x8 __attribute__((ext_vector_type(8)));
typedef float f32x4 __attribute__((ext_vector_type(4)));
typedef unsigned u32x4 __attribute__((ext_vector_type(4)));
constexpr int BM = 256, BK = 64, HALF = 128, HTB = HALF * BK * 2  , STAGE_BYTES = 8 * HTB, NXCD = 8, WGM = 8;

__host__ __device__ __forceinline__ int lds_byte(int r, int c) { const int st = (r >> 4) * 2 + (c >> 5), rr = r & 15, cc = c & 31, ob = rr * 64 + cc * 2; return st * 1024 + (ob ^ (((ob >> 9) & 1) << 5)); }
__host__ __device__ __forceinline__ void stage_rc(int b, int& R, int& C) { const int st = b / 1024, sb = b % 1024, swz = sb ^ (((sb >> 9) & 1) << 5); R = (st >> 1) * 16 + swz / 64; C = (st & 1) * 32 + (swz % 64) / 2; }
__host__ __device__ __forceinline__ int perm32(int rho) { const int n = rho >> 4, i = rho & 15; return 8 * (i >> 2) + 4 * n + (i & 3); }

struct Unit { int pm, pn; };
struct Gemm { const bf16_t* A; const bf16_t* Bt; int M, N, K; int lda; int agc; size_t ags; };

struct StaticOrder {
    int nM, nN, nwg, G, c;
    __host__ __device__ void init(int M, int N, int G_, int c_) { nM = M / BM; nN = N / BM; nwg = nM * nN; G = G_; c = c_; }
    __host__ __device__ bool next(int i, Unit& u) const {
        const long L = (long)i * G + c; if (L >= nwg) return false;
        int wgid = (int)L; { const int q = nwg / NXCD, r = nwg % NXCD, xcd = wgid % NXCD, off = wgid / NXCD; wgid = (xcd < r ? xcd * (q + 1) : r * (q + 1) + (xcd - r) * q) + off; }
        const int nig = WGM * nN, gid = wgid / nig, fm = gid * WGM, gsz = (nM - fm) < WGM ? (nM - fm) : WGM;
        u.pm = fm + ((wgid % nig) % gsz); u.pn = (wgid % nig) / gsz; return true;
    }
    __device__ __forceinline__ void a_ready(const Unit&) const {}
    __device__ __forceinline__ void done(const Unit&) const {}
};

__device__ __forceinline__ unsigned cvt_pk_bf16(float lo, float hi) { unsigned r; asm volatile("v_cvt_pk_bf16_f32 %0, %1, %2" : "=v"(r) : "v"(lo), "v"(hi)); return r; }

__device__ __forceinline__ unsigned pk_f16(float lo, float hi) {
    _Float16 a = (_Float16)lo, b = (_Float16)hi;
    return (unsigned)__builtin_bit_cast(unsigned short, a) | ((unsigned)__builtin_bit_cast(unsigned short, b) << 16);
}
__device__ __forceinline__ float fast_sigmoid(float x) { return __builtin_amdgcn_rcpf(1.0f + __expf(-x)); }
__device__ __forceinline__ float fast_tanh(float x) { return 1.0f - 2.0f * __builtin_amdgcn_rcpf(1.0f + __expf(2.0f * x)); }
template <int FMT> __device__ __forceinline__ u32x4 pack8(const f32x4& v0, const f32x4& v1) {
    u32x4 w;
    if (FMT == 0) { w.x = cvt_pk_bf16(v0[0], v0[1]); w.y = cvt_pk_bf16(v0[2], v0[3]); w.z = cvt_pk_bf16(v1[0], v1[1]); w.w = cvt_pk_bf16(v1[2], v1[3]); }
    else { w.x = pk_f16(v0[0], v0[1]); w.y = pk_f16(v0[2], v0[3]); w.z = pk_f16(v1[0], v1[1]); w.w = pk_f16(v1[2], v1[3]); }
    return w;
}
enum { EM_SWIGLU = 0, EM_RES = 1, EM_SPLIT = 2, EM_LORA1 = 3, EM_LORA2 = 4, EM_KV = 5 };
template <int MODE, int FMT  > struct Epi {
    static constexpr bool PERM = true, AFTER_DRAIN = false;
    bf16_t* O; int ldc; size_t split_stride;
    const float* Xs; float* Xd; float rs;
    const float* v0; const float* v1;
    const float* rss;
    float* rso; bf16_t* Xb;
    const bf16_t* Xsb;
    __device__ __forceinline__ void operator()(const f32x4 (&acc)[2][2][4][2], const Unit& u, int wr, int wc, int fr, int fq) const {
        const int row0 = u.pm * BM + wr * 64 + fr;
        const int lc0 = wc * 32 + 8 * fq;
#pragma unroll
        for (int ai = 0; ai < 2; ++ai)
#pragma unroll
            for (int m = 0; m < 4; ++m) {
                const size_t row = (size_t)(row0 + ai * HALF + m * 16);
                float rsc = 1.0f;
                if constexpr (MODE == EM_SWIGLU || MODE == EM_SPLIT || MODE == EM_KV) { if (rss) rsc = rsqrtf(rss[row] * (1.0f / 1024.0f) + 1e-6f); }
                float rsum = 0.f;
                if constexpr (MODE == EM_SWIGLU) {
                    const f32x4 ga = acc[ai][0][m][0], gb = acc[ai][0][m][1], ua = acc[ai][1][m][0], ub = acc[ai][1][m][1];
                    const float ce = -1.4426950408889634f * rsc, irs2 = 1.0f / (rsc * rsc);
                    f32x4 r0, r1;
#pragma unroll
                    for (int i = 0; i < 4; ++i) {
                        r0[i] = (ga[i] * ua[i]) * __builtin_amdgcn_rcpf(__builtin_amdgcn_exp2f(ga[i] * ce) * irs2 + irs2);
                        r1[i] = (gb[i] * ub[i]) * __builtin_amdgcn_rcpf(__builtin_amdgcn_exp2f(gb[i] * ce) * irs2 + irs2);
                    }
                    *(u32x4*)(O + row * ldc + u.pn * HALF + lc0) = pack8<0>(r0, r1);
                } else {
#pragma unroll
                    for (int bj = 0; bj < 2; ++bj) {
                        const int lc = bj * HALF + lc0;
                        f32x4 a0 = acc[ai][bj][m][0], a1 = acc[ai][bj][m][1];
                        if constexpr (MODE == EM_RES) {
                            const size_t off = row * 1024 + u.pn * BM + lc;
                            f32x4 x0, x1;
                            if (Xs) { x0 = *(const f32x4*)(Xs + off); x1 = *(const f32x4*)(Xs + off + 4); }
                            else { const u32x4 w = *(const u32x4*)(Xsb + off);
                                x0 = (f32x4){__builtin_bit_cast(float, w.x << 16), __builtin_bit_cast(float, w.x & 0xffff0000u), __builtin_bit_cast(float, w.y << 16), __builtin_bit_cast(float, w.y & 0xffff0000u)};
                                x1 = (f32x4){__builtin_bit_cast(float, w.z << 16), __builtin_bit_cast(float, w.z & 0xffff0000u), __builtin_bit_cast(float, w.w << 16), __builtin_bit_cast(float, w.w & 0xffff0000u)}; }
                            x0 = x0 + a0 * rs; x1 = x1 + a1 * rs;
                            if (Xd) { *(f32x4*)(Xd + off) = x0; *(f32x4*)(Xd + off + 4) = x1; }
                            if (Xb) *(u32x4*)(Xb + off) = pack8<0>(x0, x1);
                            if (rso) rsum += (x0[0] * x0[0] + x0[1] * x0[1]) + (x0[2] * x0[2] + x0[3] * x0[3]) + (x1[0] * x1[0] + x1[1] * x1[1]) + (x1[2] * x1[2] + x1[3] * x1[3]);
                        } else if constexpr (MODE == EM_SPLIT) {
                            const int t = u.pn >> 2, col = (u.pn & 3) * BM + lc;
                            *(u32x4*)(O + (size_t)t * split_stride + row * ldc + col) = pack8<FMT>(a0 * rsc, a1 * rsc);
                        } else if constexpr (MODE == EM_KV) {
                            const int t = u.pn >> 2, col = (u.pn & 3) * BM + lc;
                            if (t == 0) { const size_t rb = row >> 13, tt = row & 8191;
                                *(u32x4*)(O + ((((rb * 8 + (col >> 7)) * 128 + (tt >> 6)) * 64 + (tt & 63)) * 128 + (col & 127))) = pack8<0>(a0 * rsc, a1 * rsc); }
                            else *(u32x4*)(O + split_stride + row * ldc + col) = pack8<0>(a0 * rsc, a1 * rsc);
                        } else if constexpr (MODE == EM_LORA1) {
                            if (u.pn == 0) { if (lc < 64) { f32x4 r0, r1;
#pragma unroll
                                    for (int i = 0; i < 4; ++i) { r0[i] = fast_tanh(a0[i]); r1[i] = fast_tanh(a1[i]); }
                                    *(u32x4*)(O + row * ldc + lc) = pack8<0>(r0, r1); } }
                            else if (u.pn == 1) { if (lc < 64) *(u32x4*)(O + row * ldc + 64 + lc) = pack8<0>(a0, a1); }
                            else { f32x4 r0, r1;
#pragma unroll
                                for (int i = 0; i < 4; ++i) { r0[i] = fast_sigmoid(a0[i]); r1[i] = fast_sigmoid(a1[i]); }
                                *(u32x4*)(O + row * ldc + 128 + lc) = pack8<0>(r0, r1); }
                        } else if constexpr (MODE == EM_LORA2) {
                            const int t = u.pn >> 2, col = (u.pn & 3) * BM + lc;
                            const float* bv = t ? v1 : v0;
                            f32x4 b0 = *(const f32x4*)(bv + col), b1 = *(const f32x4*)(bv + col + 4), r0, r1;
                            const float sc = t ? 1.0f : 0.6065306597f;
#pragma unroll
                            for (int i = 0; i < 4; ++i) { r0[i] = sc * fast_sigmoid(a0[i] + b0[i]); r1[i] = sc * fast_sigmoid(a1[i] + b1[i]); }
                            *(u32x4*)(O + (size_t)t * split_stride + row * ldc + col) = pack8<1>(r0, r1);
                        }
                    }
                    if constexpr (MODE == EM_RES) { if (rso) { rsum += __shfl_xor(rsum, 16); rsum += __shfl_xor(rsum, 32); if (fq == 0) unsafeAtomicAdd(rso + row, rsum); } }
                }
            }
    }
};
template <class Epi, class Sched, bool ALIGN_EPI = false, bool SP2 = false>
__device__ __forceinline__ void gemm_phase(PG8_LAS unsigned char* lds, const Gemm g, const Sched& S, const Epi& E) {
    int tid = threadIdx.x; asm volatile("" : "+v"(tid)); const int wid = __builtin_amdgcn_readfirstlane(tid >> 6), lane = tid & 63, wr = wid >> 2, wc = wid & 3, fr = lane & 15, fq = lane >> 4;
    const int K = g.K, nt = K / BK;
    unsigned voffA[2], voffB[2];
#pragma unroll
    for (int i = 0; i < 2; ++i) { int R, C; stage_rc(tid * 16 + i * 8192, R, C); const int Rb = Epi::PERM ? ((R & ~31) + perm32(R & 31)) : R;
        voffA[i] = (unsigned)(R * g.lda + C) * 2u; voffB[i] = (unsigned)(Rb * K + C) * 2u; }
    const size_t kstep = (size_t)(BK * 2);
    const size_t hstepA = (size_t)HALF * g.lda * 2, hstepB = (size_t)HALF * K * 2;
    const size_t tstepA = 2 * hstepA, tstepB = 2 * hstepB;
    const unsigned ldsw = (unsigned)wid * 1024u;
    const int aoff = lds_byte(wr * 64 + fr, fq * 8), boff = lds_byte(wc * 32 + fr, fq * 8);
#define PG8_SA(b, h) (((b) * 2 + (h)) * HTB)
#define PG8_SB(b, h) ((4 + (b) * 2 + (h)) * HTB)
#define PG8_STAGE(bufoff, gbase, voff) do { _Pragma("unroll") for (int _i = 0; _i < 2; ++_i) \
        __builtin_amdgcn_global_load_lds((const unsigned*)((const char*)(gbase) + (voff)[_i]), (PG8_LAS unsigned*)(lds + (bufoff) + ldsw + _i * 8192), 16, 0, 0); } while (0)
#define PG8_LDA(dst, b, h) do { _Pragma("unroll") for (int m = 0; m < 4; ++m) _Pragma("unroll") for (int k = 0; k < 2; ++k) dst[m][k] = *(const PG8_LAS bf16x8*)(lds + PG8_SA(b, h) + aoff + m * 2048 + k * 1024); } while (0)
#define PG8_LDB(dst, b, h) do { _Pragma("unroll") for (int n = 0; n < 2; ++n) _Pragma("unroll") for (int k = 0; k < 2; ++k) dst[n][k] = *(const PG8_LAS bf16x8*)(lds + PG8_SB(b, h) + boff + n * 2048 + k * 1024); } while (0)
#define PG8_MMA(ai, bj, At, Bt) do { __builtin_amdgcn_s_setprio(1); _Pragma("unroll") for (int m = 0; m < 4; ++m) _Pragma("unroll") for (int n = 0; n < 2; ++n) _Pragma("unroll") for (int k = 0; k < 2; ++k) \
        acc[ai][bj][m][n] = __builtin_amdgcn_mfma_f32_16x16x32_bf16(Bt[n][k], At[m][k], acc[ai][bj][m][n], 0, 0, 0); __builtin_amdgcn_s_setprio(0); } while (0)
#define PG8_WAIT_V(n) asm volatile("s_waitcnt vmcnt(" #n ")" ::: "memory")
#define PG8_WAIT_L(n) asm volatile("s_waitcnt lgkmcnt(" #n ")" ::: "memory")
#define PG8_BAR __builtin_amdgcn_s_barrier()
#define PG8_SCHED __builtin_amdgcn_sched_barrier(0)
    Unit cur, nxt; int ui = 0;
    if (!S.next(0, cur)) return;
    f32x4 acc[2][2][4][2];
#pragma unroll
    for (int a = 0; a < 2; ++a)
#pragma unroll
        for (int b = 0; b < 2; ++b)
#pragma unroll
            for (int m = 0; m < 4; ++m)
#pragma unroll
                for (int n = 0; n < 2; ++n) acc[a][b][m][n] = (f32x4){0.f, 0.f, 0.f, 0.f};
    bf16x8 At[4][2], B0[2][2], B1[2][2];
    const char* cA = (const char*)g.A + (size_t)(cur.pn / g.agc) * g.ags + (size_t)cur.pm * tstepA; const char* cB = (const char*)g.Bt + (size_t)cur.pn * tstepB;
    S.a_ready(cur);
    if constexpr (SP2) {
        PG8_STAGE(PG8_SB(0, 0), cB, voffB); PG8_STAGE(PG8_SB(0, 1), cB + hstepB, voffB); PG8_STAGE(PG8_SA(0, 0), cA, voffA); PG8_STAGE(PG8_SA(0, 1), cA + hstepA, voffA);
        if (wr == 1) PG8_BAR;
        PG8_WAIT_V(2); PG8_BAR;
        PG8_STAGE(PG8_SB(1, 0), cB + kstep, voffB); PG8_STAGE(PG8_SA(1, 0), cA + kstep, voffA); PG8_STAGE(PG8_SB(1, 1), cB + hstepB + kstep, voffB);
        PG8_WAIT_V(6); PG8_BAR;
    } else {
        PG8_STAGE(PG8_SB(0, 0), cB, voffB); PG8_STAGE(PG8_SA(0, 0), cA, voffA); PG8_STAGE(PG8_SB(0, 1), cB + hstepB, voffB); PG8_STAGE(PG8_SA(0, 1), cA + hstepA, voffA);
        if (wr == 1) PG8_BAR;
        PG8_WAIT_V(4); PG8_BAR;
        PG8_STAGE(PG8_SB(1, 0), cB + kstep, voffB); PG8_STAGE(PG8_SA(1, 0), cA + kstep, voffA); PG8_STAGE(PG8_SB(1, 1), cB + hstepB + kstep, voffB);
        PG8_WAIT_V(6); PG8_BAR;
    }
    for (;;) {
        const bool has_next = S.next(ui + 1, nxt);
        const char* nA = has_next ? (const char*)g.A + (size_t)(nxt.pn / g.agc) * g.ags + (size_t)nxt.pm * tstepA : cA; const char* nB = has_next ? (const char*)g.Bt + (size_t)nxt.pn * tstepB : cB;
        for (int t = 0; t < nt; t += 2) {
            const bool last = (t == nt - 2);
            const char* a1 = cA + (size_t)(t + 1) * kstep;
            const char* a2 = last ? nA : cA + (size_t)(t + 2) * kstep; const char* b2 = last ? nB : cB + (size_t)(t + 2) * kstep;
            const char* a3 = a2 + kstep; const char* b3 = b2 + kstep;
            if (last && has_next) S.a_ready(nxt);
            if constexpr (SP2) {
            PG8_LDB(B0, 0, 0); PG8_LDB(B1, 0, 1); PG8_SCHED; PG8_LDA(At, 0, 0); PG8_STAGE(PG8_SA(1, 1), a1 + hstepA, voffA);
            PG8_WAIT_V(8); PG8_WAIT_L(0); PG8_BAR; PG8_MMA(0, 0, At, B0); PG8_MMA(0, 1, At, B1); PG8_BAR; PG8_SCHED;
            PG8_LDA(At, 0, 1); PG8_STAGE(PG8_SB(0, 0), b2, voffB); PG8_STAGE(PG8_SB(0, 1), b2 + hstepB, voffB); PG8_STAGE(PG8_SA(0, 0), a2, voffA);
            PG8_WAIT_V(8); PG8_WAIT_L(0); PG8_BAR; PG8_MMA(1, 0, At, B0); PG8_MMA(1, 1, At, B1); PG8_BAR; PG8_SCHED;
            PG8_LDB(B0, 1, 0); PG8_LDB(B1, 1, 1); PG8_SCHED; PG8_LDA(At, 1, 0); PG8_STAGE(PG8_SA(0, 1), a2 + hstepA, voffA);
            PG8_WAIT_V(8); PG8_WAIT_L(0); PG8_BAR; PG8_MMA(0, 0, At, B0); PG8_MMA(0, 1, At, B1); PG8_BAR; PG8_SCHED;
            PG8_LDA(At, 1, 1); PG8_STAGE(PG8_SB(1, 0), b3, voffB); PG8_STAGE(PG8_SB(1, 1), b3 + hstepB, voffB); PG8_STAGE(PG8_SA(1, 0), a3, voffA);
            PG8_WAIT_V(8); PG8_WAIT_L(0); PG8_BAR; PG8_MMA(1, 0, At, B0); PG8_MMA(1, 1, At, B1); PG8_BAR; PG8_SCHED;
            } else {
            PG8_LDB(B0, 0, 0); PG8_SCHED; PG8_LDA(At, 0, 0); PG8_STAGE(PG8_SA(1, 1), a1 + hstepA, voffA);
            PG8_WAIT_L(8); PG8_BAR; PG8_WAIT_L(0); PG8_MMA(0, 0, At, B0); PG8_BAR; PG8_SCHED;
            PG8_LDB(B1, 0, 1); PG8_STAGE(PG8_SB(0, 0), b2, voffB);
            PG8_BAR; PG8_WAIT_L(0); PG8_MMA(0, 1, At, B1); PG8_BAR;
            PG8_LDA(At, 0, 1); PG8_STAGE(PG8_SA(0, 0), a2, voffA);
            PG8_BAR; PG8_WAIT_L(0); PG8_MMA(1, 0, At, B0); PG8_BAR; PG8_SCHED;
            PG8_STAGE(PG8_SB(0, 1), b2 + hstepB, voffB);
            PG8_WAIT_V(6); PG8_BAR; PG8_MMA(1, 1, At, B1); PG8_BAR;
            PG8_LDB(B0, 1, 0); PG8_SCHED; PG8_LDA(At, 1, 0); PG8_STAGE(PG8_SA(0, 1), a2 + hstepA, voffA);
            PG8_WAIT_L(8); PG8_BAR; PG8_WAIT_L(0); PG8_MMA(0, 0, At, B0); PG8_BAR; PG8_SCHED;
            PG8_LDB(B1, 1, 1); PG8_STAGE(PG8_SB(1, 0), b3, voffB);
            PG8_BAR; PG8_WAIT_L(0); PG8_MMA(0, 1, At, B1); PG8_BAR;
            PG8_LDA(At, 1, 1); PG8_STAGE(PG8_SA(1, 0), a3, voffA);
            PG8_BAR; PG8_WAIT_L(0); PG8_MMA(1, 0, At, B0); PG8_BAR; PG8_SCHED;
            PG8_STAGE(PG8_SB(1, 1), b3 + hstepB, voffB);
            PG8_WAIT_V(6); PG8_BAR; PG8_MMA(1, 1, At, B1); PG8_BAR;
            }
        }
        if constexpr (ALIGN_EPI) { if (wr == 0) PG8_BAR; }
        if constexpr (!Epi::AFTER_DRAIN) { E(acc, cur, wr, wc, fr, fq); S.done(cur); }
        if (!has_next) break;
#pragma unroll
        for (int a = 0; a < 2; ++a)
#pragma unroll
            for (int b = 0; b < 2; ++b)
#pragma unroll
                for (int m = 0; m < 4; ++m)
#pragma unroll
                    for (int n = 0; n < 2; ++n) acc[a][b][m][n] = (f32x4){0.f, 0.f, 0.f, 0.f};
        cur = nxt; cA = nA; cB = nB; ++ui;
        if constexpr (ALIGN_EPI) { if (wr == 1) PG8_BAR; }
    }
    PG8_WAIT_V(0);
    if constexpr (!ALIGN_EPI) { if (wr == 0) PG8_BAR; }
    PG8_BAR;
    if constexpr (Epi::AFTER_DRAIN) { E.fused(acc, cur, wr, wc, fr, fq, lds, wid, lane); S.done(cur); }
#undef PG8_SA
#undef PG8_SB
#undef PG8_STAGE
#undef PG8_LDA
#undef PG8_LDB
#undef PG8_MMA
#undef PG8_WAIT_V
#undef PG8_WAIT_L
#undef PG8_BAR
#undef PG8_SCHED
}
}

#define LAS __attribute__((address_space(3)))
typedef unsigned short u16;
typedef float f32x4 __attribute__((ext_vector_type(4)));
typedef float f32x2 __attribute__((ext_vector_type(2)));
typedef unsigned u32x4 __attribute__((ext_vector_type(4)));
typedef unsigned u32x2 __attribute__((ext_vector_type(2)));
typedef short bf16x8 __attribute__((ext_vector_type(8)));
constexpr int NT = 512;
constexpr int CM = 1024, FF = 2816, TT = 8192, NB = 4, MTOK = NB * TT;
constexpr size_t MiB = 1u << 20;
constexpr size_t WS_WIN = 1 * MiB, WIN_SZ = (size_t)2 * FF * CM * 2;
constexpr size_t WS_WOUT = 45 * MiB, WOUT_SZ = (size_t)CM * FF * 2;
constexpr size_t WS_WRKV = 67 * MiB;
constexpr size_t WS_WL1 = 73 * MiB;
constexpr size_t WS_WL2 = WS_WL1 + 3 * MiB / 2;
constexpr size_t WS_WG2 = WS_WL2 + 1 * MiB;
constexpr size_t WS_WRO = 76 * MiB, WS_WKV = 78 * MiB, WS_WQ = 82 * MiB, WS_WDO = 84 * MiB;
constexpr size_t WS_S0 = 88 * MiB, SLOT = 64 * MiB;
constexpr size_t WS_LORA = WS_S0 + 6 * SLOT;
constexpr size_t WS_END = WS_LORA + 24 * MiB;
constexpr int LDS_BYTES = 159744;
constexpr float LOG2E = 1.4426950408889634f;
constexpr float LAM_INIT1 = 0.35550906759f;

struct Params { const float* in[29]; float* out; unsigned char* ws; };

__device__ __forceinline__ int otid() { int t = threadIdx.x; asm volatile("" : "+v"(t)); return t; }
__device__ __forceinline__ float bf2f(unsigned h) { return __builtin_bit_cast(float, h << 16); }
__device__ __forceinline__ float h2f(unsigned h) { return (float)__builtin_bit_cast(_Float16, (unsigned short)h); }
__device__ __forceinline__ float wave_sum(float v) {
#pragma unroll
    for (int o = 32; o > 0; o >>= 1) v += __shfl_xor(v, o);
    return v;
}
__device__ __forceinline__ float wave_max(float v) {
#pragma unroll
    for (int o = 32; o > 0; o >>= 1) v = fmaxf(v, __shfl_xor(v, o));
    return v;
}
template <int CTRL> __device__ __forceinline__ float dpp_mov(float x) {
    return __builtin_bit_cast(float, __builtin_amdgcn_update_dpp(0, __builtin_bit_cast(int, x), CTRL, 0xF, 0xF, false));
}
__device__ __forceinline__ float sum4(float x) { x += dpp_mov<0xB1>(x); x += dpp_mov<0x4E>(x); return x; }
__device__ __forceinline__ float sum8(float x) { x = sum4(x); x += dpp_mov<0x141>(x); return x; }
__device__ __forceinline__ float sum16(float x) { x = sum8(x); x += dpp_mov<0x140>(x); return x; }
typedef __bf16 bf16x2_t __attribute__((ext_vector_type(2)));
__device__ __forceinline__ unsigned cvt_pk_bf16(float lo, float hi) { const f32x2 v = {lo, hi}; const bf16x2_t b = __builtin_convertvector(v, bf16x2_t); return __builtin_bit_cast(unsigned, b); }
using pg8::pk_f16;

__device__ __forceinline__ void wprep(const float* __restrict__ src, int ld, int col0, int nvalid, int Ks,
                                      u16* __restrict__ dst, int Kd, int nrows, float* tile, int& ctr, const float* __restrict__ gain = nullptr) {
    const int tid = otid(), items_k = Kd >> 7, nitem = (nrows >> 6) * items_k, G = (int)gridDim.x;
    int t0 = ((int)blockIdx.x - ctr) % G; if (t0 < 0) t0 += G;
    for (int t = t0; t < nitem; t += G) {
        const int tn = t / items_k, tk = t - tn * items_k, n0 = tn << 6, k0 = tk << 7;
        const int kr = tid >> 4, c4 = (tid & 15) << 2;
        f32x4 v[4];
#pragma unroll
        for (int i = 0; i < 4; ++i) {
            const int k = k0 + kr + 32 * i;
            v[i] = (f32x4){0.f, 0.f, 0.f, 0.f};
            if (k < Ks && (n0 + c4) < nvalid) { v[i] = *(const f32x4*)(src + (size_t)k * ld + col0 + n0 + c4); if (gain) v[i] = v[i] * gain[k]; }
        }
#pragma unroll
        for (int i = 0; i < 4; ++i) { float* tp = tile + (kr + 32 * i) * 65 + c4; tp[0] = v[i][0]; tp[1] = v[i][1]; tp[2] = v[i][2]; tp[3] = v[i][3]; }
        __syncthreads();
        const int n = tid >> 3, ks = (tid & 7) << 3;
#pragma unroll
        for (int hh = 0; hh < 2; ++hh) {
            const float* tp = tile + (hh * 64 + ks) * 65 + n;
            u32x4 w;
            w.x = cvt_pk_bf16(tp[0], tp[65]); w.y = cvt_pk_bf16(tp[2 * 65], tp[3 * 65]); w.z = cvt_pk_bf16(tp[4 * 65], tp[5 * 65]); w.w = cvt_pk_bf16(tp[6 * 65], tp[7 * 65]);
            *(u32x4*)(dst + (size_t)(n0 + n) * Kd + k0 + hh * 64 + ks) = w;
        }
        __syncthreads();
    }
    ctr += nitem;
}

__device__ __forceinline__ void prep_phase(const Params& p, float* tile) {
    unsigned char* ws = p.ws;
    int ctr = 0;
    for (int mi = 0; mi < 4; ++mi) {
        const float* win = p.in[2] + (size_t)mi * CM * 2 * FF;
        u16* dwin = (u16*)(ws + WS_WIN + mi * WIN_SZ);
        for (int pn = 0; pn < 22; ++pn) {
            wprep(win, 2 * FF, 128 * pn, 128, CM, dwin + (size_t)(256 * pn) * CM, CM, 128, tile, ctr, p.in[1] + mi * CM);
            wprep(win, 2 * FF, FF + 128 * pn, 128, CM, dwin + (size_t)(256 * pn + 128) * CM, CM, 128, tile, ctr, p.in[1] + mi * CM);
        }
        wprep(p.in[3] + (size_t)mi * FF * CM, CM, 0, CM, FF, (u16*)(ws + WS_WOUT + mi * WOUT_SZ), FF, CM, tile, ctr);
    }
    for (int i = 0; i < 3; ++i) wprep(p.in[6] + (size_t)i * CM * CM, CM, 0, CM, CM, (u16*)(ws + WS_WRKV) + (size_t)i * CM * CM, CM, CM, tile, ctr);
    wprep(p.in[8], 64, 0, 64, CM, (u16*)(ws + WS_WL1), CM, 256, tile, ctr);
    wprep(p.in[11], 64, 0, 64, CM, (u16*)(ws + WS_WL1) + (size_t)256 * CM, CM, 256, tile, ctr);
    wprep(p.in[13], 160, 0, 160, CM, (u16*)(ws + WS_WL1) + (size_t)512 * CM, CM, 256, tile, ctr);
    wprep(p.in[9], CM, 0, CM, 64, (u16*)(ws + WS_WL2), 256, CM, tile, ctr);
    wprep(p.in[12], CM, 0, CM, 64, (u16*)(ws + WS_WL2) + (size_t)CM * 256, 256, CM, tile, ctr);
    wprep(p.in[14], CM, 0, CM, 160, (u16*)(ws + WS_WG2), 256, CM, tile, ctr);
    wprep(p.in[20], CM, 0, CM, CM, (u16*)(ws + WS_WRO), CM, CM, tile, ctr);
    wprep(p.in[22], 2 * CM, 0, 2 * CM, CM, (u16*)(ws + WS_WKV), CM, 2 * CM, tile, ctr, p.in[21]);
    wprep(p.in[24], CM, 0, CM, CM, (u16*)(ws + WS_WQ), CM, CM, tile, ctr, p.in[4] + CM);
    wprep(p.in[28], CM, 0, CM, CM, (u16*)(ws + WS_WDO), CM, CM, tile, ctr);
}

__device__ __forceinline__ void cast_phase(const float* __restrict__ X, u16* __restrict__ H, float* __restrict__ rowss) {
    const int tid_ = otid(); const int wave = tid_ >> 6, lane = tid_ & 63;
    for (int row = blockIdx.x * 8 + wave; row < MTOK; row += gridDim.x * 8) {
        const float* xr = X + (size_t)row * CM + lane * 8;
        f32x4 x[4]; float ss = 0.f;
#pragma unroll
        for (int i = 0; i < 4; ++i) { x[i] = *(const f32x4*)(xr + 512 * (i >> 1) + 4 * (i & 1)); ss += x[i][0] * x[i][0] + x[i][1] * x[i][1] + x[i][2] * x[i][2] + x[i][3] * x[i][3]; }
        ss = wave_sum(ss);
        if (lane == 0) rowss[row] = ss;
        u16* hr = H + (size_t)row * CM + lane * 8;
#pragma unroll
        for (int i = 0; i < 2; ++i) { u32x4 w; w.x = cvt_pk_bf16(x[2 * i][0], x[2 * i][1]); w.y = cvt_pk_bf16(x[2 * i][2], x[2 * i][3]); w.z = cvt_pk_bf16(x[2 * i + 1][0], x[2 * i + 1][1]); w.w = cvt_pk_bf16(x[2 * i + 1][2], x[2 * i + 1][3]);
            *(u32x4*)(hr + 512 * i) = w; }
    }
}

__device__ __forceinline__ f32x4 ld_bf16x4(const u16* p) { const u32x2 w = *(const u32x2*)p; return (f32x4){__builtin_bit_cast(float, w.x << 16), __builtin_bit_cast(float, w.x & 0xffff0000u), __builtin_bit_cast(float, w.y << 16), __builtin_bit_cast(float, w.y & 0xffff0000u)}; }
__device__ __forceinline__ void ld_bf16x8(const u16* p, f32x4& lo, f32x4& hi) {
    const u32x4 w = *(const u32x4*)p;
    lo = (f32x4){__builtin_bit_cast(float, w.x << 16), __builtin_bit_cast(float, w.x & 0xffff0000u), __builtin_bit_cast(float, w.y << 16), __builtin_bit_cast(float, w.y & 0xffff0000u)};
    hi = (f32x4){__builtin_bit_cast(float, w.z << 16), __builtin_bit_cast(float, w.z & 0xffff0000u), __builtin_bit_cast(float, w.w << 16), __builtin_bit_cast(float, w.w & 0xffff0000u)};
}
__device__ __forceinline__ void mix_phase(const u16* __restrict__ X, const float* __restrict__ g, const float* __restrict__ mu, u16* __restrict__ o0, size_t ostride) {
    const int tid_ = otid(); const int wave = tid_ >> 6, lane = tid_ & 63;
    f32x4 gg[4], mm[6][4];
#pragma unroll
    for (int i = 0; i < 4; ++i) { const int c = lane * 8 + 512 * (i >> 1) + 4 * (i & 1); gg[i] = *(const f32x4*)(g + c);
#pragma unroll
        for (int j = 0; j < 6; ++j) mm[j][i] = *(const f32x4*)(mu + j * CM + c); }
    for (int row = blockIdx.x * 8 + wave; row < MTOK; row += gridDim.x * 8) {
        const u16* xr = X + (size_t)row * CM + lane * 8;
        const bool first = (row & (TT - 1)) == 0;
        f32x4 x[4], xp[4]; float ss = 0.f, sp = 0.f;
#pragma unroll
        for (int i = 0; i < 2; ++i) {
            ld_bf16x8(xr + 512 * i, x[2 * i], x[2 * i + 1]);
            if (first) { xp[2 * i] = (f32x4){0.f, 0.f, 0.f, 0.f}; xp[2 * i + 1] = (f32x4){0.f, 0.f, 0.f, 0.f}; }
            else ld_bf16x8(xr - CM + 512 * i, xp[2 * i], xp[2 * i + 1]);
        }
#pragma unroll
        for (int i = 0; i < 4; ++i) {
            ss += x[i][0] * x[i][0] + x[i][1] * x[i][1] + x[i][2] * x[i][2] + x[i][3] * x[i][3];
            sp += xp[i][0] * xp[i][0] + xp[i][1] * xp[i][1] + xp[i][2] * xp[i][2] + xp[i][3] * xp[i][3];
        }
        ss = wave_sum(ss); sp = wave_sum(sp);
        const float rstd = rsqrtf(ss * (1.0f / CM) + 1e-6f), rstdp = rsqrtf(sp * (1.0f / CM) + 1e-6f);
        const size_t off = (size_t)row * CM + lane * 8;
        f32x4 h[4], dx[4];
#pragma unroll
        for (int i = 0; i < 4; ++i) { h[i] = x[i] * rstd * gg[i]; dx[i] = xp[i] * rstdp * gg[i] - h[i]; }
#pragma unroll
        for (int j = 0; j < 6; ++j)
#pragma unroll
            for (int i = 0; i < 2; ++i) {
                const f32x4 a = h[2 * i] + dx[2 * i] * mm[j][2 * i], c = h[2 * i + 1] + dx[2 * i + 1] * mm[j][2 * i + 1];
                u32x4 w; w.x = cvt_pk_bf16(a[0], a[1]); w.y = cvt_pk_bf16(a[2], a[3]); w.z = cvt_pk_bf16(c[0], c[1]); w.w = cvt_pk_bf16(c[2], c[3]);
                *(u32x4*)(o0 + j * ostride + off + 512 * i) = w;
            }
    }
}

template <class E> __device__ __forceinline__ void run_gemm(LAS unsigned char* l, const u16* A, int lda, int agc, size_t ags, const u16* Bt, int N, int K, const E& e) {
    pg8::Gemm g{A, Bt, MTOK, N, K, lda, agc, ags};
    pg8::StaticOrder S; S.init(MTOK, N, (int)gridDim.x, (int)blockIdx.x);
    pg8::gemm_phase<E, pg8::StaticOrder, true, true>(l, g, S, e);
}

constexpr int SC_T = 32, SC_BUF = 10752, SC_Y = 21504, SC_YSZ = 512 * 17;
__device__ __forceinline__ void scan_phase(const u16* __restrict__ R, const u16* __restrict__ Kx, const u16* __restrict__ V, const u16* __restrict__ E,
                                           const u16* __restrict__ A, const float* __restrict__ k_k, const float* __restrict__ k_a,
                                           u16* __restrict__ Y, float* sm) {
    const int tid = otid(), wave = tid >> 6, lane = tid & 63;
    const int G = (int)gridDim.x, bid = (int)blockIdx.x;
    for (int ui = bid; ui < 256; ui += G) {
        const int unit = (G == 256) ? ((ui & 7) * 32 + (ui >> 3)) : ui;
        const int bh = unit >> 2, q = unit & 3, b = bh >> 4, h = bh & 15;
        const size_t tok0 = (size_t)b * TT;
        const int nchunk = TT / SC_T;
        __syncthreads();
        if (wave >= 4) {
            const int lt = tid - 256, s = lt >> 3, seg = lt & 7;
            const int s2 = lt >> 1, half = lt & 1;
            float kkw[8], kaw[8];
#pragma unroll
            for (int j = 0; j < 8; ++j) { const int ch = h * 64 + (j >> 2) * 32 + seg * 4 + (j & 3); kkw[j] = k_k[ch]; kaw[j] = k_a[ch]; }
            u32x4 rR, rK, rE, rA, rV = {0u, 0u, 0u, 0u};
#define SC_LD2(P_) ({ const u32x2 lo_ = *(const u32x2*)((P_) + gi), hi_ = *(const u32x2*)((P_) + gi + 32); (u32x4){lo_.x, lo_.y, hi_.x, hi_.y}; })
#define SC_ISSUE(c) do { const size_t gi = (tok0 + (size_t)(c) * SC_T + s) * CM + h * 64 + seg * 4; \
            rR = SC_LD2(R); rK = SC_LD2(Kx); rE = SC_LD2(E); rA = SC_LD2(A); \
            if (lt < 64) rV = *(const u32x4*)(V + (tok0 + (size_t)(c) * SC_T + s2) * CM + h * 64 + 16 * q + half * 8); } while (0)
#define SC_PREP(bufi) do { float* Bf = sm + (bufi) * SC_BUF; \
            float kf[8], af[8], ef[8], rf[8], kkr[8]; \
            _Pragma("unroll") for (int j = 0; j < 4; ++j) { \
                kf[2 * j] = h2f(rK[j] & 0xffffu); kf[2 * j + 1] = h2f(rK[j] >> 16); af[2 * j] = h2f(rA[j] & 0xffffu); af[2 * j + 1] = h2f(rA[j] >> 16); \
                ef[2 * j] = h2f(rE[j] & 0xffffu); ef[2 * j + 1] = h2f(rE[j] >> 16); rf[2 * j] = h2f(rR[j] & 0xffffu); rf[2 * j + 1] = h2f(rR[j] >> 16); } \
            float ssq = 0.f; \
            _Pragma("unroll") for (int j = 0; j < 8; ++j) { kkr[j] = kf[j] * kkw[j]; ssq += kkr[j] * kkr[j]; } \
            ssq = sum8(ssq); const float inv = rsqrtf(fmaxf(ssq, 1e-24f)); \
            f32x4 w0, w1, p0, p1, n0, n1, b0, b1, r0, r1; \
            _Pragma("unroll") for (int j = 0; j < 4; ++j) { \
                const float kA = kkr[j] * inv, kB = kkr[j + 4] * inv; \
                w0[j] = __expf(-ef[j]); w1[j] = __expf(-ef[j + 4]); \
                p0[j] = kf[j] * (1.0f + (af[j] - 1.0f) * kaw[j]); p1[j] = kf[j + 4] * (1.0f + (af[j + 4] - 1.0f) * kaw[j + 4]); \
                n0[j] = kA; n1[j] = kB; b0[j] = kA * af[j]; b1[j] = kB * af[j + 4]; r0[j] = rf[j]; r1[j] = rf[j + 4]; } \
            const int ix = s * 64 + seg * 4; \
            *(f32x4*)(Bf + ix) = w0; *(f32x4*)(Bf + ix + 32) = w1; *(f32x4*)(Bf + 2048 + ix) = p0; *(f32x4*)(Bf + 2048 + ix + 32) = p1; \
            *(f32x4*)(Bf + 4096 + ix) = n0; *(f32x4*)(Bf + 4096 + ix + 32) = n1; *(f32x4*)(Bf + 6144 + ix) = b0; *(f32x4*)(Bf + 6144 + ix + 32) = b1; \
            *(f32x4*)(Bf + 8192 + ix) = r0; *(f32x4*)(Bf + 8192 + ix + 32) = r1; \
            if (lt < 64) { f32x4 v0, v1; \
                _Pragma("unroll") for (int j = 0; j < 2; ++j) { v0[2 * j] = h2f(rV[j] & 0xffffu); v0[2 * j + 1] = h2f(rV[j] >> 16); v1[2 * j] = h2f(rV[j + 2] & 0xffffu); v1[2 * j + 1] = h2f(rV[j + 2] >> 16); } \
                *(f32x4*)(Bf + 10240 + s2 * 16 + half * 8) = v0; *(f32x4*)(Bf + 10240 + s2 * 16 + half * 8 + 4) = v1; } } while (0)
#define SC_YOUT(c) do { const float* ypb = sm + SC_Y + ((c) & 1) * SC_YSZ; \
            _Pragma("unroll") for (int o = 0; o < 2; ++o) { const int oi = lt + 256 * o; const float* qp = ypb + oi * 17; \
                const float a0 = (qp[0] + qp[1]) + (qp[2] + qp[3]), a1 = (qp[4] + qp[5]) + (qp[6] + qp[7]), a2 = (qp[8] + qp[9]) + (qp[10] + qp[11]), a3 = (qp[12] + qp[13]) + (qp[14] + qp[15]); \
                const float yv = (a0 + a1) + (a2 + a3); \
                Y[(tok0 + (size_t)(c) * SC_T + (oi >> 4)) * CM + h * 64 + 16 * q + (oi & 15)] = (u16)(cvt_pk_bf16(yv, yv) & 0xffffu); } } while (0)
            SC_ISSUE(0);
            SC_PREP(0);
            SC_ISSUE(1);
            __syncthreads();
            for (int c = 0; c < nchunk; ++c) {
                if (c > 0) SC_YOUT(c - 1);
                if (c + 1 < nchunk) { SC_PREP((c + 1) & 1); if (c + 2 < nchunk) SC_ISSUE(c + 2); }
                __syncthreads();
            }
            SC_YOUT(nchunk - 1);
#undef SC_ISSUE
#undef SC_LD2
#undef SC_PREP
#undef SC_YOUT
        } else {
            const int c4 = lane & 15, rl = wave * 4 + (lane >> 4);
            f32x2 Sa = {0.f, 0.f}, Sb = {0.f, 0.f};
            __builtin_amdgcn_s_setprio(3);
            __syncthreads();
#define SC_LD(P, s_) do { w##P = *(const f32x4*)(Bo + (s_) * 64); k##P = *(const f32x4*)(Bo + 2048 + (s_) * 64); n##P = *(const f32x4*)(Bo + 4096 + (s_) * 64); \
            b##P = *(const f32x4*)(Bo + 6144 + (s_) * 64); r##P = *(const f32x4*)(Bo + 8192 + (s_) * 64); v##P = Vo[(s_) * 16]; } while (0)
#define SC_STEP(P, s_) do { \
            const f32x2 n01 = {n##P[0], n##P[1]}, n23 = {n##P[2], n##P[3]}, w01 = {w##P[0], w##P[1]}, w23 = {w##P[2], w##P[3]}; \
            const f32x2 k01 = {k##P[0], k##P[1]}, k23 = {k##P[2], k##P[3]}, b01 = {b##P[0], b##P[1]}, b23 = {b##P[2], b##P[3]}; \
            const f32x2 r01 = {r##P[0], r##P[1]}, r23 = {r##P[2], r##P[3]}; \
            f32x2 dd = Sa * n01; dd = Sb * n23 + dd; \
            float d = dd.x + dd.y; d = sum16(d); \
            const f32x2 vv = {v##P, v##P}; \
            f32x2 t0 = vv * k01; t0 = Sa * w01 + t0; f32x2 t1 = vv * k23; t1 = Sb * w23 + t1; \
            const f32x2 d2 = {d, d}; \
            Sa = t0 - d2 * b01; Sb = t1 - d2 * b23; \
            f32x2 yy = Sa * r01; yy = Sb * r23 + yy; \
            yo[(s_) * 272] = yy.x + yy.y; } while (0)
            for (int c = 0; c < nchunk; ++c) {
                const float* Bo = sm + (c & 1) * SC_BUF + c4 * 4;
                const float* Vo = sm + (c & 1) * SC_BUF + 10240 + rl;
                float* yo = sm + SC_Y + (c & 1) * SC_YSZ + rl * 17 + c4;
                f32x4 wA, kA, nA, bA, rA, wB, kB, nB, bB, rB, wC, kC, nC, bC, rC, wD, kD, nD, bD, rD; float vA, vB, vC, vD;
                SC_LD(A, 0); SC_LD(B, 1);
#pragma unroll
                for (int s = 0; s < SC_T; s += 4) {
                    SC_LD(C, s + 2);
                    SC_STEP(A, s);
                    SC_LD(D, s + 3);
                    SC_STEP(B, s + 1);
                    SC_LD(A, (s + 4 < SC_T) ? s + 4 : SC_T - 1);
                    SC_STEP(C, s + 2);
                    SC_LD(B, (s + 5 < SC_T) ? s + 5 : SC_T - 1);
                    SC_STEP(D, s + 3);
                }
                __syncthreads();
            }
#undef SC_LD
#undef SC_STEP
            __builtin_amdgcn_s_setprio(0);
        }
    }
}

struct PostRow { u32x4 yv[2], rv[2], kv[2], vv[2], av[2], gv[2]; };
__device__ __forceinline__ void post_load(PostRow& q, const u16* Y, const u16* R, const u16* Kx, const u16* V, const u16* A, const u16* Gt, size_t off) {
#pragma unroll
    for (int i = 0; i < 2; ++i) { q.yv[i] = *(const u32x4*)(Y + off + 8 * i); q.rv[i] = *(const u32x4*)(R + off + 8 * i); q.kv[i] = *(const u32x4*)(Kx + off + 8 * i);
        q.vv[i] = *(const u32x4*)(V + off + 8 * i); q.av[i] = *(const u32x4*)(A + off + 8 * i); q.gv[i] = *(const u32x4*)(Gt + off + 8 * i); }
}
__device__ __forceinline__ void post_row(const PostRow& q, const float (&lg)[16], const float (&lb)[16], const float (&ka)[16], const float (&rk)[16], u16* Y, size_t off) {
    float y[16], sum = 0.f, bon = 0.f;
#pragma unroll
    for (int j = 0; j < 16; ++j) {
        const unsigned wy = q.yv[j >> 3][(j >> 1) & 3], wr_ = q.rv[j >> 3][(j >> 1) & 3], wk = q.kv[j >> 3][(j >> 1) & 3], wa = q.av[j >> 3][(j >> 1) & 3];
        const unsigned sh = (j & 1) * 16;
        y[j] = bf2f((wy >> sh) & 0xffffu); sum += y[j];
        const float r = h2f((wr_ >> sh) & 0xffffu), k = h2f((wk >> sh) & 0xffffu), a = h2f((wa >> sh) & 0xffffu);
        bon += r * (k * (1.0f + (a - 1.0f) * ka[j])) * rk[j];
    }
    sum = sum4(sum); bon = sum4(bon);
    const float mean = sum * (1.0f / 64.0f);
    float var = 0.f;
#pragma unroll
    for (int j = 0; j < 16; ++j) { const float d = y[j] - mean; var += d * d; }
    var = sum4(var) * (1.0f / 64.0f);
    const float rstd = rsqrtf(var + 64e-5f);
    float o[16];
#pragma unroll
    for (int j = 0; j < 16; ++j) {
        const unsigned wv = q.vv[j >> 3][(j >> 1) & 3], wg = q.gv[j >> 3][(j >> 1) & 3]; const unsigned sh = (j & 1) * 16;
        const float v = h2f((wv >> sh) & 0xffffu), g = bf2f((wg >> sh) & 0xffffu);
        o[j] = ((y[j] - mean) * rstd * lg[j] + lb[j] + bon * v) * g;
    }
#pragma unroll
    for (int i = 0; i < 2; ++i) { u32x4 w; w.x = cvt_pk_bf16(o[8 * i], o[8 * i + 1]); w.y = cvt_pk_bf16(o[8 * i + 2], o[8 * i + 3]); w.z = cvt_pk_bf16(o[8 * i + 4], o[8 * i + 5]); w.w = cvt_pk_bf16(o[8 * i + 6], o[8 * i + 7]);
        *(u32x4*)(Y + off + 8 * i) = w; }
}
__device__ __forceinline__ void post_phase(u16* Y, const u16* __restrict__ R, const u16* __restrict__ Kx, const u16* __restrict__ V,
                                           const u16* __restrict__ A, const u16* __restrict__ Gt, const float* __restrict__ ln_g, const float* __restrict__ ln_b,
                                           const float* __restrict__ k_a, const float* __restrict__ r_k) {
    const int tid_ = otid(); const int wave = tid_ >> 6, lane = tid_ & 63, ch0 = lane * 16;
    float lg[16], lb[16], ka[16], rk[16];
#pragma unroll
    for (int j = 0; j < 16; ++j) { lg[j] = ln_g[ch0 + j]; lb[j] = ln_b[ch0 + j]; ka[j] = k_a[ch0 + j]; rk[j] = r_k[ch0 + j]; }
    const int stride = gridDim.x * 8;
    for (int row = blockIdx.x * 8 + wave; row < MTOK; row += 2 * stride) {
        const size_t off0 = (size_t)row * CM + ch0, off1 = (size_t)(row + stride) * CM + ch0;
        const bool two = (row + stride) < MTOK;
        PostRow q0, q1;
        post_load(q0, Y, R, Kx, V, A, Gt, off0);
        if (two) post_load(q1, Y, R, Kx, V, A, Gt, off1);
        post_row(q0, lg, lb, ka, rk, Y, off0);
        if (two) post_row(q1, lg, lb, ka, rk, Y, off1);
    }
}

__device__ __forceinline__ void headnorm_phase(u16* __restrict__ Hb, const float* __restrict__ gain, float scale) {
    const int tid_ = otid(); const int wave = tid_ >> 6, lane = tid_ & 63, ch0 = lane * 16;
    float gn[16];
#pragma unroll
    for (int j = 0; j < 16; ++j) gn[j] = gain[(ch0 + j) & 63] * scale;
    for (int row = blockIdx.x * 8 + wave; row < MTOK; row += gridDim.x * 8) {
        const size_t off = (size_t)row * CM + ch0;
        u32x4 xv[2]; xv[0] = *(const u32x4*)(Hb + off); xv[1] = *(const u32x4*)(Hb + off + 8);
        float x[16], ss = 0.f;
#pragma unroll
        for (int j = 0; j < 16; ++j) { const unsigned w = xv[j >> 3][(j >> 1) & 3]; x[j] = bf2f((w >> ((j & 1) * 16)) & 0xffffu); ss += x[j] * x[j]; }
        ss = sum4(ss);
        const float r = rsqrtf(ss * (1.0f / 64.0f) + 1e-6f);
#pragma unroll
        for (int i = 0; i < 2; ++i) { u32x4 w; w.x = cvt_pk_bf16(x[8 * i] * r * gn[8 * i], x[8 * i + 1] * r * gn[8 * i + 1]); w.y = cvt_pk_bf16(x[8 * i + 2] * r * gn[8 * i + 2], x[8 * i + 3] * r * gn[8 * i + 3]);
            w.z = cvt_pk_bf16(x[8 * i + 4] * r * gn[8 * i + 4], x[8 * i + 5] * r * gn[8 * i + 5]); w.w = cvt_pk_bf16(x[8 * i + 6] * r * gn[8 * i + 6], x[8 * i + 7] * r * gn[8 * i + 7]);
            *(u32x4*)(Hb + off + 8 * i) = w; }
    }
}

__device__ __forceinline__ void vt_phase(const u16* __restrict__ Vr, u16* __restrict__ VT, u16* ts) {
    const int tid = otid();
    constexpr int PITCH = 66;
    for (int unit = blockIdx.x; unit < NB * 8 * (TT / 64); unit += gridDim.x) {
        const int tt = unit & 127, h = (unit >> 7) & 7, b = unit >> 10, t0 = tt * 64;
        {
            const int tok = tid >> 3, seg = tid & 7;
            const u16* src = Vr + ((size_t)b * TT + t0 + tok) * CM + h * 128 + seg * 16;
            const u32x4 a = *(const u32x4*)src, c = *(const u32x4*)(src + 8);
#pragma unroll
            for (int j = 0; j < 4; ++j) {
                ts[(seg * 16 + 2 * j) * PITCH + tok] = (u16)(a[j] & 0xffffu); ts[(seg * 16 + 2 * j + 1) * PITCH + tok] = (u16)(a[j] >> 16);
                ts[(seg * 16 + 8 + 2 * j) * PITCH + tok] = (u16)(c[j] & 0xffffu); ts[(seg * 16 + 8 + 2 * j + 1) * PITCH + tok] = (u16)(c[j] >> 16);
            }
        }
        __syncthreads();
        {
            const int d = tid >> 2, sg = tid & 3;
            const unsigned* rowp = (const unsigned*)(ts + d * PITCH + sg * 16);
            u32x4 a, c;
            a.x = rowp[0]; a.y = rowp[1]; a.z = rowp[2]; a.w = rowp[3]; c.x = rowp[4]; c.y = rowp[5]; c.z = rowp[6]; c.w = rowp[7];
            u16* dst = VT + ((((size_t)b * 8 + h) * 128 + tt) * 128 + d) * 64 + sg * 16;
            *(u32x4*)dst = a; *(u32x4*)(dst + 8) = c;
        }
        __syncthreads();
    }
}

constexpr int AT_KP = 288, AT_VP = 160, AT_KB = 64 * AT_KP, AT_VB = 128 * AT_VP, AT_BUF = AT_KB + AT_VB;
template <bool DIAG> __device__ __forceinline__ void att_softmax(f32x4 (&st)[4], float& mrow, float& pend, f32x4 (&o)[8], f32x4& lacc, bf16x8 (&pb)[2], int kv0, int quad, int qidx) {
    if (DIAG) {
#pragma unroll
        for (int kb = 0; kb < 4; ++kb)
#pragma unroll
            for (int r = 0; r < 4; ++r) if (kv0 + kb * 16 + quad * 4 + r > qidx) st[kb][r] = -INFINITY;
    }
    float mxa = fmaxf(fmaxf(st[0][0], st[0][1]), st[0][2]), mxb = fmaxf(fmaxf(st[2][0], st[2][1]), st[2][2]);
    mxa = fmaxf(fmaxf(mxa, st[0][3]), st[1][0]); mxb = fmaxf(fmaxf(mxb, st[2][3]), st[3][0]);
    mxa = fmaxf(fmaxf(mxa, st[1][1]), st[1][2]); mxb = fmaxf(fmaxf(mxb, st[3][1]), st[3][2]);
    float mx = fmaxf(fmaxf(mxa, st[1][3]), fmaxf(mxb, st[3][3]));
    float mcmp;
    if (DIAG) { mx = fmaxf(mx, __shfl_xor(mx, 16)); mx = fmaxf(mx, __shfl_xor(mx, 32)); mcmp = mx; }
    else mcmp = pend;
    if (__any(mcmp > mrow)) {
        const float mnew = fmaxf(mrow, mcmp);
        const float alpha = __builtin_amdgcn_exp2f(mrow - mnew);
        mrow = mnew;
#pragma unroll
        for (int db = 0; db < 8; ++db) o[db] = o[db] * alpha;
        lacc = lacc * alpha;
    }
    float ex1 = 0.f;
    if (!DIAG) ex1 = fmaxf(mx, __shfl_xor(mx, 16));
    const f32x2 m2 = {mrow, mrow};
#pragma unroll
    for (int kb = 0; kb < 4; ++kb) {
        const f32x2 d0 = (f32x2){st[kb][0], st[kb][1]} - m2, d1 = (f32x2){st[kb][2], st[kb][3]} - m2;
        st[kb][0] = __builtin_amdgcn_exp2f(d0.x); st[kb][1] = __builtin_amdgcn_exp2f(d0.y); st[kb][2] = __builtin_amdgcn_exp2f(d1.x); st[kb][3] = __builtin_amdgcn_exp2f(d1.y);
    }
#pragma unroll
    for (int kp = 0; kp < 2; ++kp) {
        u32x4 w;
        w.x = cvt_pk_bf16(st[2 * kp][0], st[2 * kp][1]); w.y = cvt_pk_bf16(st[2 * kp][2], st[2 * kp][3]);
        w.z = cvt_pk_bf16(st[2 * kp + 1][0], st[2 * kp + 1][1]); w.w = cvt_pk_bf16(st[2 * kp + 1][2], st[2 * kp + 1][3]);
        pb[kp] = __builtin_bit_cast(bf16x8, w);
    }
    if (!DIAG) pend = fmaxf(ex1, __shfl_xor(ex1, 32)); else pend = mrow;
}
template <bool DIAG> __device__ __forceinline__ void att_tile(const LAS unsigned char* Ks, const LAS unsigned char* Vs, const bf16x8 (&bq)[2][2], f32x4 (&o)[2][8], f32x4 (&lacc)[2], float (&mrow)[2], float (&pend)[2],
                                                          float bbase, float slope2, int kv0, int lr, int quad, int qidx, const bf16x8& ones) {
    f32x4 st[2][4];
#pragma unroll
    for (int kb = 0; kb < 4; ++kb) {
        f32x4 bias;
#pragma unroll
        for (int r = 0; r < 4; ++r) bias[r] = bbase + slope2 * (float)(kb * 16 + r);
#pragma unroll
        for (int c = 0; c < 2; ++c) {
            const LAS unsigned char* kp = Ks + (kb * 16 + lr) * AT_KP + (c * 64 + quad * 8) * 2;
            const bf16x8 a0 = *(const LAS bf16x8*)kp, a1 = *(const LAS bf16x8*)(kp + 64);
            f32x4 z = __builtin_amdgcn_mfma_f32_16x16x32_bf16(a0, bq[c][0], bias, 0, 0, 0);
            st[c][kb] = __builtin_amdgcn_mfma_f32_16x16x32_bf16(a1, bq[c][1], z, 0, 0, 0);
        }
        if (kb == 1) __builtin_amdgcn_sched_barrier(0);
    }
    const LAS unsigned char* vb = Vs + lr * AT_VP + quad * 16;
    bf16x8 va[2], vc[4][2], vd[3][2];
#define AT_PV(db_, frag) do { _Pragma("unroll") for (int kp = 0; kp < 2; ++kp) { \
        o[0][db_] = __builtin_amdgcn_mfma_f32_16x16x32_bf16(frag[kp], pb[0][kp], o[0][db_], 0, 0, 0); \
        o[1][db_] = __builtin_amdgcn_mfma_f32_16x16x32_bf16(frag[kp], pb[1][kp], o[1][db_], 0, 0, 0); } } while (0)
#pragma unroll
    for (int kp = 0; kp < 2; ++kp) va[kp] = *(const LAS bf16x8*)(vb + kp * 64);
    bf16x8 pb[2][2];
    att_softmax<DIAG>(st[0], mrow[0], pend[0], o[0], lacc[0], pb[0], kv0, quad, qidx);
    att_softmax<DIAG>(st[1], mrow[1], pend[1], o[1], lacc[1], pb[1], kv0, quad, qidx);
#pragma unroll
    for (int db = 0; db < 4; ++db)
#pragma unroll
        for (int kp = 0; kp < 2; ++kp) vc[db][kp] = *(const LAS bf16x8*)(vb + (db + 1) * 16 * AT_VP + kp * 64);
#pragma unroll
    for (int kp = 0; kp < 2; ++kp) {
        lacc[0] = __builtin_amdgcn_mfma_f32_16x16x32_bf16(ones, pb[0][kp], lacc[0], 0, 0, 0);
        lacc[1] = __builtin_amdgcn_mfma_f32_16x16x32_bf16(ones, pb[1][kp], lacc[1], 0, 0, 0);
    }
    AT_PV(0, va);
    AT_PV(1, vc[0]); AT_PV(2, vc[1]);
#pragma unroll
    for (int db = 0; db < 3; ++db)
#pragma unroll
        for (int kp = 0; kp < 2; ++kp) vd[db][kp] = *(const LAS bf16x8*)(vb + (db + 5) * 16 * AT_VP + kp * 64);
    AT_PV(3, vc[2]); AT_PV(4, vc[3]);
    AT_PV(5, vd[0]); AT_PV(6, vd[1]); AT_PV(7, vd[2]);
#undef AT_PV
}
__device__ __forceinline__ void attn_phase(const u16* __restrict__ Q, const u16* __restrict__ Kn, const u16* __restrict__ VT, u16* __restrict__ O,
                                           const float* __restrict__ q_norm, const float* __restrict__ k_norm, const float* __restrict__ lam,
                                           const float* __restrict__ subln, unsigned char* sm) {
    const int tid = otid(), wave = tid >> 6, lane = tid & 63, lr = lane & 15, quad = lane >> 4;
    const int G = (int)gridDim.x, bid = (int)blockIdx.x;
    float lam_full, thr;
    {
        const float l0 = lam[lane] * lam[64 + lane], l1 = lam[128 + lane] * lam[192 + lane];
        lam_full = __expf(wave_sum(l0)) - __expf(wave_sum(l1)) + LAM_INIT1;
        const float gq = wave_max(fabsf(q_norm[lane])), gk = wave_max(fabsf(k_norm[lane]));
        thr = 2.0f * (8.0f * gq * gk) + 30.0f;
    }
    const u32x4 onesw = {0x3F803F80u, 0x3F803F80u, 0x3F803F80u, 0x3F803F80u};
    const bf16x8 ones = __builtin_bit_cast(bf16x8, onesw);
    const int nunits = NB * 8 * (TT / 128);
    if (__builtin_amdgcn_readfirstlane(tid) >= 256) __builtin_amdgcn_s_setprio(1);
    for (int rr = 0;; ++rr) {
        const int pos = rr * G + ((rr & 1) ? (G - 1 - bid) : bid);
        if (rr * G >= nunits) break;
        if (pos >= nunits) continue;
        const int b = pos & 3, qt = 63 - ((pos >> 2) & 63), h = 7 - (pos >> 8);
        const int q0 = qt * 128;
        const float slope = __builtin_amdgcn_exp2f(-(float)(h + 1));
        const float slope2 = slope * LOG2E;
        int Wi = (int)(thr / slope) + 1; if (Wi > TT) Wi = TT;
        int kvs = q0 - Wi; if (kvs < 0) kvs = 0; kvs &= ~63;
        const int ntile = (q0 + 128 - kvs) >> 6;
        const size_t tokb = (size_t)b * TT;
        const int qidx = q0 + wave * 16 + lr;
        bf16x8 bq[2][2];
#pragma unroll
        for (int c = 0; c < 2; ++c) {
            u32x4 raw[2]; float qf[16], ss = 0.f;
#pragma unroll
            for (int kk = 0; kk < 2; ++kk) raw[kk] = *(const u32x4*)(Q + (tokb + qidx) * CM + h * 128 + c * 64 + kk * 32 + quad * 8);
#pragma unroll
            for (int j = 0; j < 16; ++j) { const unsigned w = raw[j >> 3][(j >> 1) & 3]; qf[j] = bf2f((w >> ((j & 1) * 16)) & 0xffffu); ss += qf[j] * qf[j]; }
            ss += __shfl_xor(ss, 16); ss += __shfl_xor(ss, 32);
            const float rq = rsqrtf(ss * (1.0f / 64.0f) + 1e-6f) * (0.125f * LOG2E);
#pragma unroll
            for (int kk = 0; kk < 2; ++kk) {
                const f32x4 g0 = *(const f32x4*)(q_norm + kk * 32 + quad * 8), g1 = *(const f32x4*)(q_norm + kk * 32 + quad * 8 + 4);
                u32x4 w;
                w.x = cvt_pk_bf16(qf[8 * kk + 0] * rq * g0[0], qf[8 * kk + 1] * rq * g0[1]); w.y = cvt_pk_bf16(qf[8 * kk + 2] * rq * g0[2], qf[8 * kk + 3] * rq * g0[3]);
                w.z = cvt_pk_bf16(qf[8 * kk + 4] * rq * g1[0], qf[8 * kk + 5] * rq * g1[1]); w.w = cvt_pk_bf16(qf[8 * kk + 6] * rq * g1[2], qf[8 * kk + 7] * rq * g1[3]);
                bq[c][kk] = __builtin_bit_cast(bf16x8, w);
            }
        }
        f32x4 o[2][8], lacc[2];
#pragma unroll
        for (int c = 0; c < 2; ++c) {
            lacc[c] = (f32x4){0.f, 0.f, 0.f, 0.f};
#pragma unroll
            for (int db = 0; db < 8; ++db) o[c][db] = (f32x4){0.f, 0.f, 0.f, 0.f};
        }
        float mrow[2] = {-1e30f, -1e30f}, pend[2] = {-1e30f, -1e30f};
        u32x4 kregA[2], vregA[2], kregB[2], vregB[2];
        const u16* kbase = Kn + ((size_t)b * 8 + h) * 128 * 8192 + tid * 8;
        const u16* vbase = VT + ((size_t)b * 8 + h) * 128 * 8192 + tid * 8;
#define AT_LOAD(P, kv0) do { _Pragma("unroll") for (int i = 0; i < 2; ++i) { \
            kreg##P[i] = *(const u32x4*)(kbase + (size_t)((kv0) >> 6) * 8192 + 4096 * i); \
            vreg##P[i] = *(const u32x4*)(vbase + (size_t)((kv0) >> 6) * 8192 + 4096 * i); } } while (0)
#define AT_STORE(P, bufi) do { unsigned char* bb = sm + (bufi) * AT_BUF; _Pragma("unroll") for (int i = 0; i < 2; ++i) { const int pc = tid + 512 * i; \
            *(u32x4*)(bb + (pc >> 4) * AT_KP + (pc & 15) * 16) = kreg##P[i]; \
            const int sg = pc & 7, k0 = (sg & 3) * 8, ps = (sg >> 2) * 32 + ((k0 & 15) >> 2) * 8 + (k0 >> 4) * 4; \
            unsigned char* vp = bb + AT_KB + (pc >> 3) * AT_VP + ps * 2; \
            *(u32x2*)vp = (u32x2){vreg##P[i].x, vreg##P[i].y}; *(u32x2*)(vp + 16) = (u32x2){vreg##P[i].z, vreg##P[i].w}; } } while (0)
#define AT_COMPUTE(idx_) do { const int kv0 = kvs + (ntile - 1 - (idx_)) * 64; \
            if (kv0 <= q0 + wave * 16 + 15) { const LAS unsigned char* Ks = (const LAS unsigned char*)sm + ((idx_) & 1) * AT_BUF; \
                const float bbase = slope2 * (float)(kv0 + quad * 4 - q0); \
                if (kv0 + 63 > q0 + wave * 16) att_tile<true>(Ks, Ks + AT_KB, bq, o, lacc, mrow, pend, bbase, slope2, kv0, lr, quad, qidx, ones); \
                else att_tile<false>(Ks, Ks + AT_KB, bq, o, lacc, mrow, pend, bbase, slope2, kv0, lr, quad, qidx, ones); } } while (0)
        const int kvtop = kvs + (ntile - 1) * 64;
        __syncthreads();
        AT_LOAD(A, kvtop); AT_STORE(A, 0);
        AT_LOAD(A, kvtop - 64);
        if (ntile > 2) AT_LOAD(B, kvtop - 128);
        __syncthreads();
        for (int idx = 0; idx < ntile; idx += 2) {
            AT_COMPUTE(idx);
            if (idx + 1 < ntile) { AT_STORE(A, 1); if (idx + 3 < ntile) AT_LOAD(A, kvtop - 64 * (idx + 3)); }
            __syncthreads();
            if (idx + 1 < ntile) {
                AT_COMPUTE(idx + 1);
                if (idx + 2 < ntile) { AT_STORE(B, 0); if (idx + 4 < ntile) AT_LOAD(B, kvtop - 64 * (idx + 4)); }
                __syncthreads();
            }
        }
#undef AT_COMPUTE
#undef AT_LOAD
#undef AT_STORE
        const float i0 = 1.0f / lacc[0][0], i1 = lam_full / lacc[1][0];
        float ss = 0.f;
#pragma unroll
        for (int db = 0; db < 8; ++db)
#pragma unroll
            for (int r = 0; r < 4; ++r) { const float v = o[0][db][r] * i0 - o[1][db][r] * i1; o[0][db][r] = v; ss += v * v; }
        ss += __shfl_xor(ss, 16); ss += __shfl_xor(ss, 32);
        const float rn = rsqrtf(ss * (1.0f / 128.0f) + 1e-5f) * (1.0f - LAM_INIT1);
        u16* op = O + (tokb + qidx) * CM + h * 128 + quad * 4;
#pragma unroll
        for (int db = 0; db < 8; ++db) {
            const f32x4 sb = *(const f32x4*)(subln + db * 16 + quad * 4);
            u32x2 w; w.x = cvt_pk_bf16(o[0][db][0] * rn * sb[0], o[0][db][1] * rn * sb[1]); w.y = cvt_pk_bf16(o[0][db][2] * rn * sb[2], o[0][db][3] * rn * sb[3]);
            *(u32x2*)(op + db * 16) = w;
        }
    }
    __builtin_amdgcn_s_setprio(0);
}

#define XB_TMO      128
#define XB_XCNT(j)  (256  + 64 * (j))
#define XB_XSUB(j)  (1280 + 64 * (j))
#define XB_XGEN(j)  (2304 + 64 * (j))
#define XB_TOP      3328
#define XB_TOPGEN   3392
#define XCD_BAR_WORDS 3456
#define XB_SPIN_CAP (1u << 18)
__device__ __forceinline__ unsigned xb_ld(unsigned* p)              { return __hip_atomic_load(p, __ATOMIC_RELAXED, __HIP_MEMORY_SCOPE_AGENT); }
__device__ __forceinline__ unsigned xb_add(unsigned* p, unsigned v) { return __hip_atomic_fetch_add(p, v, __ATOMIC_RELAXED, __HIP_MEMORY_SCOPE_AGENT); }
__device__ __forceinline__ unsigned xb_xcc_id() { return (unsigned)__builtin_amdgcn_s_getreg((3 << 11) | 20) & 0xFu; }
#define XB_SPIN(cond, bar) do { unsigned _sp = 0; while (cond) { __builtin_amdgcn_s_sleep(1); \
    if ((++_sp & 255u) == 0u) { if (xb_ld(&(bar)[XB_TMO])) break; if (_sp > XB_SPIN_CAP) { atomicAdd(&(bar)[XB_TMO], 1u); break; } } } } while (0)
struct XcdBarrier { unsigned* bar; unsigned x; volatile LAS unsigned* st; };
__device__ __forceinline__ XcdBarrier xcd_barrier_post(unsigned* bar, volatile LAS unsigned* st) {
    XcdBarrier b; b.bar = bar; b.x = xb_xcc_id(); b.st = st;
    if (threadIdx.x == 0) (void)xb_add(&bar[XB_XCNT(b.x)], 1u);
    return b;
}
__device__ __forceinline__ void xcd_barrier_complete(unsigned* bar, unsigned x, unsigned& nloc, unsigned& nx) {
    const unsigned G = gridDim.x * gridDim.y * gridDim.z;
    unsigned sum, cnt, mine, sp = 0u;
    for (;;) {
        sum = 0u; cnt = 0u; mine = 0u;
#pragma unroll
        for (unsigned j = 0; j < 16; ++j) { const unsigned c = xb_ld(&bar[XB_XCNT(j)]); sum += c; cnt += (c > 0u) ? 1u : 0u; mine = (j == x) ? c : mine; }
        if (sum == G) break;
        __builtin_amdgcn_s_sleep(1);
        if ((++sp & 255u) == 0u) { if (xb_ld(&bar[XB_TMO])) break; if (sp > XB_SPIN_CAP) { atomicAdd(&bar[XB_TMO], 1u); break; } }
    }
    nloc = mine > 0u ? mine : 1u; nx = cnt > 0u ? cnt : 1u;
}
__device__ __forceinline__ void xcd_barrier(const XcdBarrier& b) {
    asm volatile("s_waitcnt vmcnt(0)" ::: "memory");
    __syncthreads();
    if (threadIdx.x == 0) {
        unsigned* bar = b.bar;
        __builtin_amdgcn_s_waitcnt(0);
        unsigned nloc = b.st[0], nx = b.st[1];
        if (nloc == 0u) { xcd_barrier_complete(bar, b.x, nloc, nx); b.st[0] = nloc; b.st[1] = nx; }
        const unsigned old = xb_add(&bar[XB_XSUB(b.x)], 1u);
        const unsigned gen = old / nloc;
        if (old + 1u == (gen + 1u) * nloc) {
            __builtin_amdgcn_fence(__ATOMIC_RELEASE, "agent");
            asm volatile("s_waitcnt vmcnt(0)" ::: "memory");
            const unsigned og = xb_add(&bar[XB_TOP], 1u);
            const unsigned tg = og / nx;
            if (og + 1u == (tg + 1u) * nx) xb_add(&bar[XB_TOPGEN], 1u);
            else XB_SPIN(xb_ld(&bar[XB_TOPGEN]) == tg, bar);
            __builtin_amdgcn_fence(__ATOMIC_ACQUIRE, "agent");
            xb_add(&bar[XB_XGEN(b.x)], 1u);
            asm volatile("s_waitcnt vmcnt(0)" ::: "memory");
        } else {
            XB_SPIN(xb_ld(&bar[XB_XGEN(b.x)]) == gen, bar);
            __builtin_amdgcn_fence(__ATOMIC_ACQUIRE, "agent");
            asm volatile("s_waitcnt vmcnt(0)" ::: "memory");
        }
    }
    __syncthreads();
}

constexpr size_t WS_BAR = 0;
constexpr size_t WS_RSS = 65536;
constexpr size_t CTL_BYTES = WS_RSS + 5 * (size_t)MTOK * 4;
static_assert(CTL_BYTES <= 1 * MiB, "control region");
constexpr int LDS_ST_OFF = 159488;

__global__ void __launch_bounds__(NT, 2) yoco_fwd(Params p) {
    extern __shared__ __attribute__((aligned(16))) unsigned char lds[];
    cg::grid_group grid = cg::this_grid();
    LAS unsigned char* l3 = (LAS unsigned char*)lds;
    unsigned char* ws = p.ws;
    float* X = p.out;
    u16* S0 = (u16*)(ws + WS_S0); u16* S1 = (u16*)(ws + WS_S0 + SLOT); u16* S2 = (u16*)(ws + WS_S0 + 2 * SLOT);
    u16* S3 = (u16*)(ws + WS_S0 + 3 * SLOT); u16* S4 = (u16*)(ws + WS_S0 + 4 * SLOT); u16* S5 = (u16*)(ws + WS_S0 + 5 * SLOT);
    u16* LORA = (u16*)(ws + WS_LORA);
    float* RSS = (float*)(ws + WS_RSS);
    const size_t SLOT_E = SLOT / 2;
    constexpr int NOGRP = 1 << 20;
    volatile LAS unsigned* st = (volatile LAS unsigned*)(l3 + LDS_ST_OFF);
    if (threadIdx.x < 2) st[threadIdx.x] = 0u;
    __syncthreads();
    const XcdBarrier bar = xcd_barrier_post((unsigned*)(ws + WS_BAR), st);
#define SYNC() xcd_barrier(bar)
#define EPI(MODE, FMT, O_, ldc_, ss_, Xs_, Xd_, rs_, v0_, v1_, rss_, rso_, Xb_) pg8::Epi<pg8::MODE, FMT> e{O_, ldc_, ss_, Xs_, Xd_, rs_, v0_, v1_, rss_, rso_, Xb_, nullptr}
#define EPIR(Xs_, Xsb_, Xd_, Xb_, rs_, rso_) pg8::Epi<pg8::EM_RES, 0> e{nullptr, 0, 0, Xs_, Xd_, rs_, nullptr, nullptr, nullptr, rso_, Xb_, Xsb_}

    prep_phase(p, (float*)lds);
    cast_phase(p.in[0], S3, RSS);
    grid.sync();
    u16* XB = (u16*)p.out;
    { EPI(EM_SWIGLU, 0, S0, FF, 0, nullptr, nullptr, 0.f, nullptr, nullptr, RSS, nullptr, nullptr);
      run_gemm(l3, S3, CM, NOGRP, 0, (const u16*)(ws + WS_WIN), 2 * FF, CM, e); }
    SYNC();
    { EPIR(p.in[0], nullptr, nullptr, XB, 0.5f, nullptr);
      run_gemm(l3, S0, FF, NOGRP, 0, (const u16*)(ws + WS_WOUT), CM, FF, e); }
    SYNC();
    mix_phase(XB, p.in[4], p.in[5], S0, SLOT_E);
    SYNC();
    { EPI(EM_LORA1, 0, LORA, 384, 0, nullptr, nullptr, 0.f, nullptr, nullptr, nullptr, nullptr, nullptr);
      run_gemm(l3, S3, CM, 1, SLOT, (const u16*)(ws + WS_WL1), 768, CM, e); }
    SYNC();
    { EPI(EM_SPLIT, 1, S3, CM, SLOT_E, nullptr, nullptr, 0.f, nullptr, nullptr, nullptr, nullptr, nullptr);
      run_gemm(l3, S0, CM, 4, SLOT, (const u16*)(ws + WS_WRKV), 3 * CM, CM, e); }
    SYNC();
    { EPI(EM_LORA2, 1, S0, CM, SLOT_E, nullptr, nullptr, 0.f, p.in[7], p.in[10], nullptr, nullptr, nullptr);
      run_gemm(l3, LORA, 384, 4, 64 * 2, (const u16*)(ws + WS_WL2), 2 * CM, 256, e); }
    SYNC();
    scan_phase(S3, S4, S5, S0, S1, p.in[15], p.in[16], S2, (float*)lds);
    SYNC();
    { EPI(EM_SPLIT, 0, S0, CM, SLOT_E, nullptr, nullptr, 0.f, nullptr, nullptr, nullptr, nullptr, nullptr);
      run_gemm(l3, LORA + 128, 384, NOGRP, 0, (const u16*)(ws + WS_WG2), CM, 256, e); }
    SYNC();
    post_phase(S2, S3, S4, S5, S1, S0, p.in[18], p.in[19], p.in[16], p.in[17]);
    SYNC();
    { EPIR(nullptr, XB, nullptr, XB, 1.0f, RSS + MTOK);
      run_gemm(l3, S2, CM, NOGRP, 0, (const u16*)(ws + WS_WRO), CM, CM, e); }
    SYNC();
    { EPI(EM_SWIGLU, 0, S0, FF, 0, nullptr, nullptr, 0.f, nullptr, nullptr, RSS + MTOK, nullptr, nullptr);
      run_gemm(l3, XB, CM, NOGRP, 0, (const u16*)(ws + WS_WIN + WIN_SZ), 2 * FF, CM, e); }
    SYNC();
    { EPIR(nullptr, XB, nullptr, XB, 0.5f, RSS + 2 * MTOK);
      run_gemm(l3, S0, FF, NOGRP, 0, (const u16*)(ws + WS_WOUT + WOUT_SZ), CM, FF, e); }
    SYNC();
    { EPI(EM_SWIGLU, 0, S0, FF, 0, nullptr, nullptr, 0.f, nullptr, nullptr, RSS + 2 * MTOK, nullptr, nullptr);
      run_gemm(l3, XB, CM, NOGRP, 0, (const u16*)(ws + WS_WIN + 2 * WIN_SZ), 2 * FF, CM, e); }
    { EPI(EM_KV, 0, S4, CM, SLOT_E, nullptr, nullptr, 0.f, nullptr, nullptr, RSS + 2 * MTOK, nullptr, nullptr);
      run_gemm(l3, XB, CM, NOGRP, 0, (const u16*)(ws + WS_WKV), 2 * CM, CM, e); }
    SYNC();
    headnorm_phase(S4, p.in[23], 1.0f);
    vt_phase(S5, S3, (u16*)lds);
    { EPIR(nullptr, XB, nullptr, XB, 0.5f, RSS + 3 * MTOK);
      run_gemm(l3, S0, FF, NOGRP, 0, (const u16*)(ws + WS_WOUT + 2 * WOUT_SZ), CM, FF, e); }
    SYNC();
    { EPI(EM_SPLIT, 0, S0, CM, SLOT_E, nullptr, nullptr, 0.f, nullptr, nullptr, RSS + 3 * MTOK, nullptr, nullptr);
      run_gemm(l3, XB, CM, NOGRP, 0, (const u16*)(ws + WS_WQ), CM, CM, e); }
    SYNC();
    attn_phase(S0, S4, S3, S1, p.in[25], p.in[23], p.in[26], p.in[27], lds);
    SYNC();
    { EPIR(nullptr, XB, nullptr, S5, 1.0f, RSS + 4 * MTOK);
      run_gemm(l3, S1, CM, NOGRP, 0, (const u16*)(ws + WS_WDO), CM, CM, e); }
    SYNC();
    { EPI(EM_SWIGLU, 0, S0, FF, 0, nullptr, nullptr, 0.f, nullptr, nullptr, RSS + 4 * MTOK, nullptr, nullptr);
      run_gemm(l3, S5, CM, NOGRP, 0, (const u16*)(ws + WS_WIN + 3 * WIN_SZ), 2 * FF, CM, e); }
    SYNC();
    { EPIR(nullptr, S5, X, nullptr, 0.5f, nullptr);
      run_gemm(l3, S0, FF, NOGRP, 0, (const u16*)(ws + WS_WOUT + 3 * WOUT_SZ), CM, FF, e); }
#undef SYNC
#undef EPI
#undef EPIR
}

extern "C" void kernel_launch(void* const* d_in, const int* in_sizes, int n_in, void* d_out, int out_size, void* d_ws, size_t ws_size, hipStream_t stream) {
    static int grid_blocks = 0;
    if (grid_blocks == 0) {
        if (n_in != 29 || out_size != MTOK * CM || ws_size < WS_END) { fprintf(stderr, "kernel_launch: unexpected shapes (n_in %d out %d ws %zu)\n", n_in, out_size, ws_size); grid_blocks = -1; return; }
        int dev = 0, cus = 0, per_cu = 0;
        (void)hipGetDevice(&dev);
        (void)hipDeviceGetAttribute(&cus, hipDeviceAttributeMultiprocessorCount, dev);
        if (hipFuncSetAttribute((const void*)yoco_fwd, hipFuncAttributeMaxDynamicSharedMemorySize, LDS_BYTES) != hipSuccess) { fprintf(stderr, "hipFuncSetAttribute failed\n"); grid_blocks = -1; return; }
        if (hipOccupancyMaxActiveBlocksPerMultiprocessor(&per_cu, (const void*)yoco_fwd, NT, LDS_BYTES) != hipSuccess || per_cu < 1) { fprintf(stderr, "occupancy query failed (%d)\n", per_cu); per_cu = 1; }
        (void)hipGetLastError();
        grid_blocks = cus * per_cu;
        if (grid_blocks > 256) grid_blocks = 256;
    }
    if (grid_blocks < 0) return;
    (void)hipMemsetAsync((char*)d_ws, 0, CTL_BYTES, stream);
    Params p{};
    for (int i = 0; i < 29; ++i) p.in[i] = (const float*)d_in[i];
    p.out = (float*)d_out; p.ws = (unsigned char*)d_ws;
    void* args[] = {&p};
    hipError_t e = hipLaunchCooperativeKernel((const void*)yoco_fwd, dim3(grid_blocks), dim3(NT), args, LDS_BYTES, stream);
    if (e != hipSuccess) fprintf(stderr, "cooperative launch failed: %s (grid %d)\n", hipGetErrorString(e), grid_blocks);
}
```

```cpp
#include <hip/hip_runtime.h>
#include <hip/hip_cooperative_groups.h>
#include <cstdio>
#include <cstdint>
namespace cg = cooperative_groups;

namespace pg8 {
#define PG8_LAS __attribute__((address_space(3)))
typedef unsigned short bf16_t;
typedef short bf16x8 __attribute__((ext_vector_type(8)));
typedef float f32x4 __attribute__((ext_vector_type(4)));
typedef unsigned u32x4 __attribute__((ext_vector_type(4)));
constexpr int BM = 256, BK = 64, HALF = 128, HTB = HALF * BK * 2  , STAGE_BYTES = 8 * HTB, NXCD = 8, WGM = 8;

__host__ __device__ __forceinline__ int lds_byte(int r, int c) { const int st = (r >> 4) * 2 + (c >> 5), rr = r & 15, cc = c & 31, ob = rr * 64 + cc * 2; return st * 1024 + (ob ^ (((ob >> 9) & 1) << 5)); }
__host__ __device__ __forceinline__ void stage_rc(int b, int& R, int& C) { const int st = b / 1024, sb = b % 1024, swz = sb ^ (((sb >> 9) & 1) << 5); R = (st >> 1) * 16 + swz / 64; C = (st & 1) * 32 + (swz % 64) / 2; }
__host__ __device__ __forceinline__ int perm32(int rho) { const int n = rho >> 4, i = rho & 15; return 8 * (i >> 2) + 4 * n + (i & 3); }

struct Unit { int pm, pn; };
struct Gemm { const bf16_t* A; const bf16_t* Bt; int M, N, K; int lda; int agc; size_t ags; };

struct StaticOrder {
    int nM, nN, nwg, G, c;
    __host__ __device__ void init(int M, int N, int G_, int c_) { nM = M / BM; nN = N / BM; nwg = nM * nN; G = G_; c = c_; }
    __host__ __device__ bool next(int i, Unit& u) const {
        const long L = (long)i * G + c; if (L >= nwg) return false;
        int wgid = (int)L; { const int q = nwg / NXCD, r = nwg % NXCD, xcd = wgid % NXCD, off = wgid / NXCD; wgid = (xcd < r ? xcd * (q + 1) : r * (q + 1) + (xcd - r) * q) + off; }
        const int nig = WGM * nN, gid = wgid / nig, fm = gid * WGM, gsz = (nM - fm) < WGM ? (nM - fm) : WGM;
        u.pm = fm + ((wgid % nig) % gsz); u.pn = (wgid % nig) / gsz; return true;
    }
    __device__ __forceinline__ void a_ready(const Unit&) const {}
    __device__ __forceinline__ void done(const Unit&) const {}
};

__device__ __forceinline__ unsigned cvt_pk_bf16(float lo, float hi) { unsigned r; asm volatile("v_cvt_pk_bf16_f32 %0, %1, %2" : "=v"(r) : "v"(lo), "v"(hi)); return r; }

__device__ __forceinline__ unsigned pk_f16(float lo, float hi) {
    _Float16 a = (_Float16)lo, b = (_Float16)hi;
    return (unsigned)__builtin_bit_cast(unsigned short, a) | ((unsigned)__builtin_bit_cast(unsigned short, b) << 16);
}
__device__ __forceinline__ float fast_sigmoid(float x) { return __builtin_amdgcn_rcpf(1.0f + __expf(-x)); }
__device__ __forceinline__ float fast_tanh(float x) { return 1.0f - 2.0f * __builtin_amdgcn_rcpf(1.0f + __expf(2.0f * x)); }
template <int FMT> __device__ __forceinline__ u32x4 pack8(const f32x4& v0, const f32x4& v1) {
    u32x4 w;
    if (FMT == 0) { w.x = cvt_pk_bf16(v0[0], v0[1]); w.y = cvt_pk_bf16(v0[2], v0[3]); w.z = cvt_pk_bf16(v1[0], v1[1]); w.w = cvt_pk_bf16(v1[2], v1[3]); }
    else { w.x = pk_f16(v0[0], v0[1]); w.y = pk_f16(v0[2], v0[3]); w.z = pk_f16(v1[0], v1[1]); w.w = pk_f16(v1[2], v1[3]); }
    return w;
}
enum { EM_SWIGLU = 0, EM_RES = 1, EM_SPLIT = 2, EM_LORA1 = 3, EM_LORA2 = 4, EM_KV = 5 };
template <int MODE, int FMT  > struct Epi {
    static constexpr bool PERM = true, AFTER_DRAIN = false;
    bf16_t* O; int ldc; size_t split_stride;
    const float* Xs; float* Xd; float rs;
    const float* v0; const float* v1;
    const float* rss;
    float* rso; bf16_t* Xb;
    const bf16_t* Xsb;
    __device__ __forceinline__ void operator()(const f32x4 (&acc)[2][2][4][2], const Unit& u, int wr, int wc, int fr, int fq) const {
        const int row0 = u.pm * BM + wr * 64 + fr;
        const int lc0 = wc * 32 + 8 * fq;
        float rsv[2][4]; u32x4 xin[2][4][2];
#pragma unroll
        for (int ai = 0; ai < 2; ++ai)
#pragma unroll
            for (int m = 0; m < 4; ++m) {
                const size_t row = (size_t)(row0 + ai * HALF + m * 16);
                rsv[ai][m] = 0.f;
                if constexpr (MODE == EM_SWIGLU || MODE == EM_SPLIT || MODE == EM_KV) { if (rss) rsv[ai][m] = rss[row]; }
                if constexpr (MODE == EM_RES) { if (!Xs) {
#pragma unroll
                    for (int bj = 0; bj < 2; ++bj) xin[ai][m][bj] = *(const u32x4*)(Xsb + row * 1024 + u.pn * BM + bj * HALF + lc0); } }
            }
#pragma unroll
        for (int ai = 0; ai < 2; ++ai)
#pragma unroll
            for (int m = 0; m < 4; ++m) {
                const size_t row = (size_t)(row0 + ai * HALF + m * 16);
                float rsc = 1.0f;
                if constexpr (MODE == EM_SWIGLU || MODE == EM_SPLIT || MODE == EM_KV) { if (rss) rsc = rsqrtf(rsv[ai][m] * (1.0f / 1024.0f) + 1e-6f); }
                float rsum = 0.f;
                if constexpr (MODE == EM_SWIGLU) {
                    const f32x4 ga = acc[ai][0][m][0], gb = acc[ai][0][m][1], ua = acc[ai][1][m][0], ub = acc[ai][1][m][1];
                    const float ce = -1.4426950408889634f * rsc, irs2 = 1.0f / (rsc * rsc);
                    f32x4 r0, r1;
#pragma unroll
                    for (int i = 0; i < 4; ++i) {
                        r0[i] = (ga[i] * ua[i]) * __builtin_amdgcn_rcpf(__builtin_amdgcn_exp2f(ga[i] * ce) * irs2 + irs2);
                        r1[i] = (gb[i] * ub[i]) * __builtin_amdgcn_rcpf(__builtin_amdgcn_exp2f(gb[i] * ce) * irs2 + irs2);
                    }
                    *(u32x4*)(O + row * ldc + u.pn * HALF + lc0) = pack8<0>(r0, r1);
                } else {
#pragma unroll
                    for (int bj = 0; bj < 2; ++bj) {
                        const int lc = bj * HALF + lc0;
                        f32x4 a0 = acc[ai][bj][m][0], a1 = acc[ai][bj][m][1];
                        if constexpr (MODE == EM_RES) {
                            const size_t off = row * 1024 + u.pn * BM + lc;
                            f32x4 x0, x1;
                            if (Xs) { x0 = *(const f32x4*)(Xs + off); x1 = *(const f32x4*)(Xs + off + 4); }
                            else { const u32x4 w = xin[ai][m][bj];
                                x0 = (f32x4){__builtin_bit_cast(float, w.x << 16), __builtin_bit_cast(float, w.x & 0xffff0000u), __builtin_bit_cast(float, w.y << 16), __builtin_bit_cast(float, w.y & 0xffff0000u)};
                                x1 = (f32x4){__builtin_bit_cast(float, w.z << 16), __builtin_bit_cast(float, w.z & 0xffff0000u), __builtin_bit_cast(float, w.w << 16), __builtin_bit_cast(float, w.w & 0xffff0000u)}; }
                            x0 = x0 + a0 * rs; x1 = x1 + a1 * rs;
                            if (Xd) { *(f32x4*)(Xd + off) = x0; *(f32x4*)(Xd + off + 4) = x1; }
                            if (Xb) *(u32x4*)(Xb + off) = pack8<0>(x0, x1);
                            if (rso) rsum += (x0[0] * x0[0] + x0[1] * x0[1]) + (x0[2] * x0[2] + x0[3] * x0[3]) + (x1[0] * x1[0] + x1[1] * x1[1]) + (x1[2] * x1[2] + x1[3] * x1[3]);
                        } else if constexpr (MODE == EM_SPLIT) {
                            const int t = u.pn >> 2, col = (u.pn & 3) * BM + lc;
                            *(u32x4*)(O + (size_t)t * split_stride + row * ldc + col) = pack8<FMT>(a0 * rsc, a1 * rsc);
                        } else if constexpr (MODE == EM_KV) {
                            const int t = u.pn >> 2, col = (u.pn & 3) * BM + lc;
                            if (t == 0) { const size_t rb = row >> 13, tt = row & 8191;
                                *(u32x4*)(O + ((((rb * 8 + (col >> 7)) * 128 + (tt >> 6)) * 64 + (tt & 63)) * 128 + (col & 127))) = pack8<0>(a0 * rsc, a1 * rsc); }
                            else *(u32x4*)(O + split_stride + row * ldc + col) = pack8<0>(a0 * rsc, a1 * rsc);
                        } else if constexpr (MODE == EM_LORA1) {
                            if (u.pn == 0) { if (lc < 64) { f32x4 r0, r1;
#pragma unroll
                                    for (int i = 0; i < 4; ++i) { r0[i] = fast_tanh(a0[i]); r1[i] = fast_tanh(a1[i]); }
                                    *(u32x4*)(O + row * ldc + lc) = pack8<0>(r0, r1); } }
                            else if (u.pn == 1) { if (lc < 64) *(u32x4*)(O + row * ldc + 64 + lc) = pack8<0>(a0, a1); }
                            else { f32x4 r0, r1;
#pragma unroll
                                for (int i = 0; i < 4; ++i) { r0[i] = fast_sigmoid(a0[i]); r1[i] = fast_sigmoid(a1[i]); }
                                *(u32x4*)(O + row * ldc + 128 + lc) = pack8<0>(r0, r1); }
                        } else if constexpr (MODE == EM_LORA2) {
                            const int t = u.pn >> 2, col = (u.pn & 3) * BM + lc;
                            const float* bv = t ? v1 : v0;
                            f32x4 b0 = *(const f32x4*)(bv + col), b1 = *(const f32x4*)(bv + col + 4), r0, r1;
                            const float sc = t ? 1.0f : 0.6065306597f;
#pragma unroll
                            for (int i = 0; i < 4; ++i) { r0[i] = sc * fast_sigmoid(a0[i] + b0[i]); r1[i] = sc * fast_sigmoid(a1[i] + b1[i]); }
                            *(u32x4*)(O + (size_t)t * split_stride + row * ldc + col) = pack8<1>(r0, r1);
                        }
                    }
                    if constexpr (MODE == EM_RES) { if (rso) { rsum += __shfl_xor(rsum, 16); rsum += __shfl_xor(rsum, 32); if (fq == 0) unsafeAtomicAdd(rso + row, rsum); } }
                }
            }
    }
};
template <class Epi, class Sched, bool ALIGN_EPI = false, bool SP2 = false>
__device__ __forceinline__ void gemm_phase(PG8_LAS unsigned char* lds, const Gemm g, const Sched& S, const Epi& E) {
    int tid = threadIdx.x; asm volatile("" : "+v"(tid)); const int wid = __builtin_amdgcn_readfirstlane(tid >> 6), lane = tid & 63, wr = wid >> 2, wc = wid & 3, fr = lane & 15, fq = lane >> 4;
    const int K = g.K, nt = K / BK;
    unsigned voffA[2], voffB[2];
#pragma unroll
    for (int i = 0; i < 2; ++i) { int R, C; stage_rc(tid * 16 + i * 8192, R, C); const int Rb = Epi::PERM ? ((R & ~31) + perm32(R & 31)) : R;
        voffA[i] = (unsigned)(R * g.lda + C) * 2u; voffB[i] = (unsigned)(Rb * K + C) * 2u; }
    const size_t kstep = (size_t)(BK * 2);
    const size_t hstepA = (size_t)HALF * g.lda * 2, hstepB = (size_t)HALF * K * 2;
    const size_t tstepA = 2 * hstepA, tstepB = 2 * hstepB;
    const unsigned ldsw = (unsigned)wid * 1024u;
    const int aoff = lds_byte(wr * 64 + fr, fq * 8), boff = lds_byte(wc * 32 + fr, fq * 8);
#define PG8_SA(b, h) (((b) * 2 + (h)) * HTB)
#define PG8_SB(b, h) ((4 + (b) * 2 + (h)) * HTB)
#define PG8_STAGE(bufoff, gbase, voff) do { _Pragma("unroll") for (int _i = 0; _i < 2; ++_i) \
        __builtin_amdgcn_global_load_lds((const unsigned*)((const char*)(gbase) + (voff)[_i]), (PG8_LAS unsigned*)(lds + (bufoff) + ldsw + _i * 8192), 16, 0, 0); } while (0)
#define PG8_LDA(dst, b, h) do { _Pragma("unroll") for (int m = 0; m < 4; ++m) _Pragma("unroll") for (int k = 0; k < 2; ++k) dst[m][k] = *(const PG8_LAS bf16x8*)(lds + PG8_SA(b, h) + aoff + m * 2048 + k * 1024); } while (0)
#define PG8_LDB(dst, b, h) do { _Pragma("unroll") for (int n = 0; n < 2; ++n) _Pragma("unroll") for (int k = 0; k < 2; ++k) dst[n][k] = *(const PG8_LAS bf16x8*)(lds + PG8_SB(b, h) + boff + n * 2048 + k * 1024); } while (0)
#define PG8_MMA(ai, bj, At, Bt) do { __builtin_amdgcn_s_setprio(1); _Pragma("unroll") for (int m = 0; m < 4; ++m) _Pragma("unroll") for (int n = 0; n < 2; ++n) _Pragma("unroll") for (int k = 0; k < 2; ++k) \
        acc[ai][bj][m][n] = __builtin_amdgcn_mfma_f32_16x16x32_bf16(Bt[n][k], At[m][k], acc[ai][bj][m][n], 0, 0, 0); __builtin_amdgcn_s_setprio(0); } while (0)
#define PG8_WAIT_V(n) asm volatile("s_waitcnt vmcnt(" #n ")" ::: "memory")
#define PG8_WAIT_L(n) asm volatile("s_waitcnt lgkmcnt(" #n ")" ::: "memory")
#define PG8_BAR __builtin_amdgcn_s_barrier()
#define PG8_SCHED __builtin_amdgcn_sched_barrier(0)
    Unit cur, nxt; int ui = 0;
    if (!S.next(0, cur)) return;
    f32x4 acc[2][2][4][2];
#pragma unroll
    for (int a = 0; a < 2; ++a)
#pragma unroll
        for (int b = 0; b < 2; ++b)
#pragma unroll
            for (int m = 0; m < 4; ++m)
#pragma unroll
                for (int n = 0; n < 2; ++n) acc[a][b][m][n] = (f32x4){0.f, 0.f, 0.f, 0.f};
    bf16x8 At[4][2], B0[2][2], B1[2][2];
    const char* cA = (const char*)g.A + (size_t)(cur.pn / g.agc) * g.ags + (size_t)cur.pm * tstepA; const char* cB = (const char*)g.Bt + (size_t)cur.pn * tstepB;
    S.a_ready(cur);
    if constexpr (SP2) {
        PG8_STAGE(PG8_SB(0, 0), cB, voffB); PG8_STAGE(PG8_SB(0, 1), cB + hstepB, voffB); PG8_STAGE(PG8_SA(0, 0), cA, voffA); PG8_STAGE(PG8_SA(0, 1), cA + hstepA, voffA);
        if (wr == 1) PG8_BAR;
        PG8_WAIT_V(2); PG8_BAR;
        PG8_STAGE(PG8_SB(1, 0), cB + kstep, voffB); PG8_STAGE(PG8_SA(1, 0), cA + kstep, voffA); PG8_STAGE(PG8_SB(1, 1), cB + hstepB + kstep, voffB);
        PG8_WAIT_V(6); PG8_BAR;
    } else {
        PG8_STAGE(PG8_SB(0, 0), cB, voffB); PG8_STAGE(PG8_SA(0, 0), cA, voffA); PG8_STAGE(PG8_SB(0, 1), cB + hstepB, voffB); PG8_STAGE(PG8_SA(0, 1), cA + hstepA, voffA);
        if (wr == 1) PG8_BAR;
        PG8_WAIT_V(4); PG8_BAR;
        PG8_STAGE(PG8_SB(1, 0), cB + kstep, voffB); PG8_STAGE(PG8_SA(1, 0), cA + kstep, voffA); PG8_STAGE(PG8_SB(1, 1), cB + hstepB + kstep, voffB);
        PG8_WAIT_V(6); PG8_BAR;
    }
    for (;;) {
        const bool has_next = S.next(ui + 1, nxt);
        const char* nA = has_next ? (const char*)g.A + (size_t)(nxt.pn / g.agc) * g.ags + (size_t)nxt.pm * tstepA : cA; const char* nB = has_next ? (const char*)g.Bt + (size_t)nxt.pn * tstepB : cB;
        for (int t = 0; t < nt; t += 2) {
            const bool last = (t == nt - 2);
            const char* a1 = cA + (size_t)(t + 1) * kstep;
            const char* a2 = last ? nA : cA + (size_t)(t + 2) * kstep; const char* b2 = last ? nB : cB + (size_t)(t + 2) * kstep;
            const char* a3 = a2 + kstep; const char* b3 = b2 + kstep;
            if (last && has_next) S.a_ready(nxt);
            if constexpr (SP2) {
            PG8_LDB(B0, 0, 0); PG8_LDB(B1, 0, 1); PG8_SCHED; PG8_LDA(At, 0, 0); PG8_STAGE(PG8_SA(1, 1), a1 + hstepA, voffA);
            PG8_WAIT_V(8); PG8_WAIT_L(0); PG8_BAR; PG8_MMA(0, 0, At, B0); PG8_MMA(0, 1, At, B1); PG8_BAR; PG8_SCHED;
            PG8_LDA(At, 0, 1); PG8_STAGE(PG8_SB(0, 0), b2, voffB); PG8_STAGE(PG8_SB(0, 1), b2 + hstepB, voffB); PG8_STAGE(PG8_SA(0, 0), a2, voffA);
            PG8_WAIT_V(8); PG8_WAIT_L(0); PG8_BAR; PG8_MMA(1, 0, At, B0); PG8_MMA(1, 1, At, B1); PG8_BAR; PG8_SCHED;
            PG8_LDB(B0, 1, 0); PG8_LDB(B1, 1, 1); PG8_SCHED; PG8_LDA(At, 1, 0); PG8_STAGE(PG8_SA(0, 1), a2 + hstepA, voffA);
            PG8_WAIT_V(8); PG8_WAIT_L(0); PG8_BAR; PG8_MMA(0, 0, At, B0); PG8_MMA(0, 1, At, B1); PG8_BAR; PG8_SCHED;
            PG8_LDA(At, 1, 1); PG8_STAGE(PG8_SB(1, 0), b3, voffB); PG8_STAGE(PG8_SB(1, 1), b3 + hstepB, voffB); PG8_STAGE(PG8_SA(1, 0), a3, voffA);
            PG8_WAIT_V(8); PG8_WAIT_L(0); PG8_BAR; PG8_MMA(1, 0, At, B0); PG8_MMA(1, 1, At, B1); PG8_BAR; PG8_SCHED;
            } else {
            PG8_LDB(B0, 0, 0); PG8_SCHED; PG8_LDA(At, 0, 0); PG8_STAGE(PG8_SA(1, 1), a1 + hstepA, voffA);
            PG8_WAIT_L(8); PG8_BAR; PG8_WAIT_L(0); PG8_MMA(0, 0, At, B0); PG8_BAR; PG8_SCHED;
            PG8_LDB(B1, 0, 1); PG8_STAGE(PG8_SB(0, 0), b2, voffB);
            PG8_BAR; PG8_WAIT_L(0); PG8_MMA(0, 1, At, B1); PG8_BAR;
            PG8_LDA(At, 0, 1); PG8_STAGE(PG8_SA(0, 0), a2, voffA);
            PG8_BAR; PG8_WAIT_L(0); PG8_MMA(1, 0, At, B0); PG8_BAR; PG8_SCHED;
            PG8_STAGE(PG8_SB(0, 1), b2 + hstepB, voffB);
            PG8_WAIT_V(6); PG8_BAR; PG8_MMA(1, 1, At, B1); PG8_BAR;
            PG8_LDB(B0, 1, 0); PG8_SCHED; PG8_LDA(At, 1, 0); PG8_STAGE(PG8_SA(0, 1), a2 + hstepA, voffA);
            PG8_WAIT_L(8); PG8_BAR; PG8_WAIT_L(0); PG8_MMA(0, 0, At, B0); PG8_BAR; PG8_SCHED;
            PG8_LDB(B1, 1, 1); PG8_STAGE(PG8_SB(1, 0), b3, voffB);
            PG8_BAR; PG8_WAIT_L(0); PG8_MMA(0, 1, At, B1); PG8_BAR;
            PG8_LDA(At, 1, 1); PG8_STAGE(PG8_SA(1, 0), a3, voffA);
            PG8_BAR; PG8_WAIT_L(0); PG8_MMA(1, 0, At, B0); PG8_BAR; PG8_SCHED;
            PG8_STAGE(PG8_SB(1, 1), b3 + hstepB, voffB);
            PG8_WAIT_V(6); PG8_BAR; PG8_MMA(1, 1, At, B1); PG8_BAR;
            }
        }
        if constexpr (ALIGN_EPI) { if (wr == 0) PG8_BAR; }
        if constexpr (!Epi::AFTER_DRAIN) { E(acc, cur, wr, wc, fr, fq); S.done(cur); }
        if (!has_next) break;
#pragma unroll
        for (int a = 0; a < 2; ++a)
#pragma unroll
            for (int b = 0; b < 2; ++b)
#pragma unroll
                for (int m = 0; m < 4; ++m)
#pragma unroll
                    for (int n = 0; n < 2; ++n) acc[a][b][m][n] = (f32x4){0.f, 0.f, 0.f, 0.f};
        cur = nxt; cA = nA; cB = nB; ++ui;
        if constexpr (ALIGN_EPI) { if (wr == 1) PG8_BAR; }
    }
    PG8_WAIT_V(0);
    if constexpr (!ALIGN_EPI) { if (wr == 0) PG8_BAR; }
    PG8_BAR;
    if constexpr (Epi::AFTER_DRAIN) { E.fused(acc, cur, wr, wc, fr, fq, lds, wid, lane); S.done(cur); }
#undef PG8_SA
#undef PG8_SB
#undef PG8_STAGE
#undef PG8_LDA
#undef PG8_LDB
#undef PG8_MMA
#undef PG8_WAIT_V
#undef PG8_WAIT_L
#undef PG8_BAR
#undef PG8_SCHED
}
}

#define LAS __attribute__((address_space(3)))
typedef unsigned short u16;
typedef float f32x4 __attribute__((ext_vector_type(4)));
typedef float f32x2 __attribute__((ext_vector_type(2)));
typedef unsigned u32x4 __attribute__((ext_vector_type(4)));
typedef unsigned u32x2 __attribute__((ext_vector_type(2)));
typedef short bf16x8 __attribute__((ext_vector_type(8)));
constexpr int NT = 512;
constexpr int CM = 1024, FF = 2816, TT = 8192, NB = 4, MTOK = NB * TT;
constexpr size_t MiB = 1u << 20;
constexpr size_t WS_WIN = 1 * MiB, WIN_SZ = (size_t)2 * FF * CM * 2;
constexpr size_t WS_WOUT = 45 * MiB, WOUT_SZ = (size_t)CM * FF * 2;
constexpr size_t WS_WRKV = 67 * MiB;
constexpr size_t WS_WL1 = 73 * MiB;
constexpr size_t WS_WL2 = WS_WL1 + 3 * MiB / 2;
constexpr size_t WS_WG2 = WS_WL2 + 1 * MiB;
constexpr size_t WS_WRO = 76 * MiB, WS_WKV = 78 * MiB, WS_WQ = 82 * MiB, WS_WDO = 84 * MiB;
constexpr size_t WS_S0 = 88 * MiB, SLOT = 64 * MiB;
constexpr size_t WS_LORA = WS_S0 + 6 * SLOT;
constexpr size_t WS_END = WS_LORA + 24 * MiB;
constexpr int LDS_BYTES = 159744;
constexpr float LOG2E = 1.4426950408889634f;
constexpr float LAM_INIT1 = 0.35550906759f;

struct Params { const float* in[29]; float* out; unsigned char* ws; };

__device__ __forceinline__ int otid() { int t = threadIdx.x; asm volatile("" : "+v"(t)); return t; }
__device__ __forceinline__ float bf2f(unsigned h) { return __builtin_bit_cast(float, h << 16); }
__device__ __forceinline__ float h2f(unsigned h) { return (float)__builtin_bit_cast(_Float16, (unsigned short)h); }
__device__ __forceinline__ float wave_sum(float v) {
#pragma unroll
    for (int o = 32; o > 0; o >>= 1) v += __shfl_xor(v, o);
    return v;
}
__device__ __forceinline__ float wave_max(float v) {
#pragma unroll
    for (int o = 32; o > 0; o >>= 1) v = fmaxf(v, __shfl_xor(v, o));
    return v;
}
template <int CTRL> __device__ __forceinline__ float dpp_mov(float x) {
    return __builtin_bit_cast(float, __builtin_amdgcn_update_dpp(0, __builtin_bit_cast(int, x), CTRL, 0xF, 0xF, false));
}
__device__ __forceinline__ float sum4(float x) { x += dpp_mov<0xB1>(x); x += dpp_mov<0x4E>(x); return x; }
__device__ __forceinline__ float sum8(float x) { x = sum4(x); x += dpp_mov<0x141>(x); return x; }
__device__ __forceinline__ float sum16(float x) { x = sum8(x); x += dpp_mov<0x140>(x); return x; }
typedef __bf16 bf16x2_t __attribute__((ext_vector_type(2)));
__device__ __forceinline__ unsigned cvt_pk_bf16(float lo, float hi) { const f32x2 v = {lo, hi}; const bf16x2_t b = __builtin_convertvector(v, bf16x2_t); return __builtin_bit_cast(unsigned, b); }
using pg8::pk_f16;

__device__ __forceinline__ void wprep(const float* __restrict__ src, int ld, int col0, int nvalid, int Ks,
                                      u16* __restrict__ dst, int Kd, int nrows, float* tile, int& ctr, const float* __restrict__ gain = nullptr) {
    const int tid = otid(), items_k = Kd >> 7, nitem = (nrows >> 6) * items_k, G = (int)gridDim.x;
    int t0 = ((int)blockIdx.x - ctr) % G; if (t0 < 0) t0 += G;
    for (int t = t0; t < nitem; t += G) {
        const int tn = t / items_k, tk = t - tn * items_k, n0 = tn << 6, k0 = tk << 7;
        const int kr = tid >> 4, c4 = (tid & 15) << 2;
        f32x4 v[4];
#pragma unroll
        for (int i = 0; i < 4; ++i) {
            const int k = k0 + kr + 32 * i;
            v[i] = (f32x4){0.f, 0.f, 0.f, 0.f};
            if (k < Ks && (n0 + c4) < nvalid) { v[i] = *(const f32x4*)(src + (size_t)k * ld + col0 + n0 + c4); if (gain) v[i] = v[i] * gain[k]; }
        }
#pragma unroll
        for (int i = 0; i < 4; ++i) { float* tp = tile + (kr + 32 * i) * 65 + c4; tp[0] = v[i][0]; tp[1] = v[i][1]; tp[2] = v[i][2]; tp[3] = v[i][3]; }
        __syncthreads();
        const int n = tid >> 3, ks = (tid & 7) << 3;
#pragma unroll
        for (int hh = 0; hh < 2; ++hh) {
            const float* tp = tile + (hh * 64 + ks) * 65 + n;
            u32x4 w;
            w.x = cvt_pk_bf16(tp[0], tp[65]); w.y = cvt_pk_bf16(tp[2 * 65], tp[3 * 65]); w.z = cvt_pk_bf16(tp[4 * 65], tp[5 * 65]); w.w = cvt_pk_bf16(tp[6 * 65], tp[7 * 65]);
            *(u32x4*)(dst + (size_t)(n0 + n) * Kd + k0 + hh * 64 + ks) = w;
        }
        __syncthreads();
    }
    ctr += nitem;
}

__device__ __forceinline__ void prep_phase(const Params& p, float* tile) {
    unsigned char* ws = p.ws;
    int ctr = 0;
    for (int mi = 0; mi < 4; ++mi) {
        const float* win = p.in[2] + (size_t)mi * CM * 2 * FF;
        u16* dwin = (u16*)(ws + WS_WIN + mi * WIN_SZ);
        for (int pn = 0; pn < 22; ++pn) {
            wprep(win, 2 * FF, 128 * pn, 128, CM, dwin + (size_t)(256 * pn) * CM, CM, 128, tile, ctr, p.in[1] + mi * CM);
            wprep(win, 2 * FF, FF + 128 * pn, 128, CM, dwin + (size_t)(256 * pn + 128) * CM, CM, 128, tile, ctr, p.in[1] + mi * CM);
        }
        wprep(p.in[3] + (size_t)mi * FF * CM, CM, 0, CM, FF, (u16*)(ws + WS_WOUT + mi * WOUT_SZ), FF, CM, tile, ctr);
    }
    for (int i = 0; i < 3; ++i) wprep(p.in[6] + (size_t)i * CM * CM, CM, 0, CM, CM, (u16*)(ws + WS_WRKV) + (size_t)i * CM * CM, CM, CM, tile, ctr);
    wprep(p.in[8], 64, 0, 64, CM, (u16*)(ws + WS_WL1), CM, 256, tile, ctr);
    wprep(p.in[11], 64, 0, 64, CM, (u16*)(ws + WS_WL1) + (size_t)256 * CM, CM, 256, tile, ctr);
    wprep(p.in[13], 160, 0, 160, CM, (u16*)(ws + WS_WL1) + (size_t)512 * CM, CM, 256, tile, ctr);
    wprep(p.in[9], CM, 0, CM, 64, (u16*)(ws + WS_WL2), 256, CM, tile, ctr);
    wprep(p.in[12], CM, 0, CM, 64, (u16*)(ws + WS_WL2) + (size_t)CM * 256, 256, CM, tile, ctr);
    wprep(p.in[14], CM, 0, CM, 160, (u16*)(ws + WS_WG2), 256, CM, tile, ctr);
    wprep(p.in[20], CM, 0, CM, CM, (u16*)(ws + WS_WRO), CM, CM, tile, ctr);
    wprep(p.in[22], 2 * CM, 0, 2 * CM, CM, (u16*)(ws + WS_WKV), CM, 2 * CM, tile, ctr, p.in[21]);
    wprep(p.in[24], CM, 0, CM, CM, (u16*)(ws + WS_WQ), CM, CM, tile, ctr, p.in[4] + CM);
    wprep(p.in[28], CM, 0, CM, CM, (u16*)(ws + WS_WDO), CM, CM, tile, ctr);
}

__device__ __forceinline__ void cast_phase(const float* __restrict__ X, u16* __restrict__ H, float* __restrict__ rowss) {
    const int tid_ = otid(); const int wave = tid_ >> 6, lane = tid_ & 63;
    for (int row = blockIdx.x * 8 + wave; row < MTOK; row += gridDim.x * 8) {
        const float* xr = X + (size_t)row * CM + lane * 8;
        f32x4 x[4]; float ss = 0.f;
#pragma unroll
        for (int i = 0; i < 4; ++i) { x[i] = *(const f32x4*)(xr + 512 * (i >> 1) + 4 * (i & 1)); ss += x[i][0] * x[i][0] + x[i][1] * x[i][1] + x[i][2] * x[i][2] + x[i][3] * x[i][3]; }
        ss = wave_sum(ss);
        if (lane == 0) rowss[row] = ss;
        u16* hr = H + (size_t)row * CM + lane * 8;
#pragma unroll
        for (int i = 0; i < 2; ++i) { u32x4 w; w.x = cvt_pk_bf16(x[2 * i][0], x[2 * i][1]); w.y = cvt_pk_bf16(x[2 * i][2], x[2 * i][3]); w.z = cvt_pk_bf16(x[2 * i + 1][0], x[2 * i + 1][1]); w.w = cvt_pk_bf16(x[2 * i + 1][2], x[2 * i + 1][3]);
            *(u32x4*)(hr + 512 * i) = w; }
    }
}

__device__ __forceinline__ f32x4 ld_bf16x4(const u16* p) { const u32x2 w = *(const u32x2*)p; return (f32x4){__builtin_bit_cast(float, w.x << 16), __builtin_bit_cast(float, w.x & 0xffff0000u), __builtin_bit_cast(float, w.y << 16), __builtin_bit_cast(float, w.y & 0xffff0000u)}; }
__device__ __forceinline__ void ld_bf16x8(const u16* p, f32x4& lo, f32x4& hi) {
    const u32x4 w = *(const u32x4*)p;
    lo = (f32x4){__builtin_bit_cast(float, w.x << 16), __builtin_bit_cast(float, w.x & 0xffff0000u), __builtin_bit_cast(float, w.y << 16), __builtin_bit_cast(float, w.y & 0xffff0000u)};
    hi = (f32x4){__builtin_bit_cast(float, w.z << 16), __builtin_bit_cast(float, w.z & 0xffff0000u), __builtin_bit_cast(float, w.w << 16), __builtin_bit_cast(float, w.w & 0xffff0000u)};
}
__device__ __forceinline__ void mix_phase(const u16* __restrict__ X, const float* __restrict__ g, const float* __restrict__ mu, u16* __restrict__ o0, size_t ostride) {
    const int tid_ = otid(); const int wave = tid_ >> 6, lane = tid_ & 63;
    f32x4 gg[4], mm[6][4];
#pragma unroll
    for (int i = 0; i < 4; ++i) { const int c = lane * 8 + 512 * (i >> 1) + 4 * (i & 1); gg[i] = *(const f32x4*)(g + c);
#pragma unroll
        for (int j = 0; j < 6; ++j) mm[j][i] = *(const f32x4*)(mu + j * CM + c); }
    for (int row = blockIdx.x * 8 + wave; row < MTOK; row += gridDim.x * 8) {
        const u16* xr = X + (size_t)row * CM + lane * 8;
        const bool first = (row & (TT - 1)) == 0;
        f32x4 x[4], xp[4]; float ss = 0.f, sp = 0.f;
#pragma unroll
        for (int i = 0; i < 2; ++i) {
            ld_bf16x8(xr + 512 * i, x[2 * i], x[2 * i + 1]);
            if (first) { xp[2 * i] = (f32x4){0.f, 0.f, 0.f, 0.f}; xp[2 * i + 1] = (f32x4){0.f, 0.f, 0.f, 0.f}; }
            else ld_bf16x8(xr - CM + 512 * i, xp[2 * i], xp[2 * i + 1]);
        }
#pragma unroll
        for (int i = 0; i < 4; ++i) {
            ss += x[i][0] * x[i][0] + x[i][1] * x[i][1] + x[i][2] * x[i][2] + x[i][3] * x[i][3];
            sp += xp[i][0] * xp[i][0] + xp[i][1] * xp[i][1] + xp[i][2] * xp[i][2] + xp[i][3] * xp[i][3];
        }
        ss = wave_sum(ss); sp = wave_sum(sp);
        const float rstd = rsqrtf(ss * (1.0f / CM) + 1e-6f), rstdp = rsqrtf(sp * (1.0f / CM) + 1e-6f);
        const size_t off = (size_t)row * CM + lane * 8;
        f32x4 h[4], dx[4];
#pragma unroll
        for (int i = 0; i < 4; ++i) { h[i] = x[i] * rstd * gg[i]; dx[i] = xp[i] * rstdp * gg[i] - h[i]; }
#pragma unroll
        for (int j = 0; j < 6; ++j)
#pragma unroll
            for (int i = 0; i < 2; ++i) {
                const f32x4 a = h[2 * i] + dx[2 * i] * mm[j][2 * i], c = h[2 * i + 1] + dx[2 * i + 1] * mm[j][2 * i + 1];
                u32x4 w; w.x = cvt_pk_bf16(a[0], a[1]); w.y = cvt_pk_bf16(a[2], a[3]); w.z = cvt_pk_bf16(c[0], c[1]); w.w = cvt_pk_bf16(c[2], c[3]);
                *(u32x4*)(o0 + j * ostride + off + 512 * i) = w;
            }
    }
}

template <class E> __device__ __forceinline__ void run_gemm(LAS unsigned char* l, const u16* A, int lda, int agc, size_t ags, const u16* Bt, int N, int K, const E& e) {
    pg8::Gemm g{A, Bt, MTOK, N, K, lda, agc, ags};
    pg8::StaticOrder S; S.init(MTOK, N, (int)gridDim.x, (int)blockIdx.x);
    pg8::gemm_phase<E, pg8::StaticOrder, true, true>(l, g, S, e);
}

constexpr int SC_T = 32, SC_BUF = 10752, SC_Y = 21504, SC_YSZ = 512 * 17;
__device__ __forceinline__ void scan_phase(const u16* __restrict__ R, const u16* __restrict__ Kx, const u16* __restrict__ V, const u16* __restrict__ E,
                                           const u16* __restrict__ A, const float* __restrict__ k_k, const float* __restrict__ k_a,
                                           u16* __restrict__ Y, float* sm) {
    const int tid = otid(), wave = tid >> 6, lane = tid & 63;
    const int G = (int)gridDim.x, bid = (int)blockIdx.x;
    for (int ui = bid; ui < 256; ui += G) {
        const int unit = (G == 256) ? ((ui & 7) * 32 + (ui >> 3)) : ui;
        const int bh = unit >> 2, q = unit & 3, b = bh >> 4, h = bh & 15;
        const size_t tok0 = (size_t)b * TT;
        const int nchunk = TT / SC_T;
        __syncthreads();
        if (wave >= 4) {
            const int lt = tid - 256, s = lt >> 3, seg = lt & 7;
            const int s2 = lt >> 1, half = lt & 1;
            float kkw[8], kaw[8];
#pragma unroll
            for (int j = 0; j < 8; ++j) { const int ch = h * 64 + (j >> 2) * 32 + seg * 4 + (j & 3); kkw[j] = k_k[ch]; kaw[j] = k_a[ch]; }
            u32x4 rR, rK, rE, rA, rV = {0u, 0u, 0u, 0u};
#define SC_LD2(P_) ({ const u32x2 lo_ = *(const u32x2*)((P_) + gi), hi_ = *(const u32x2*)((P_) + gi + 32); (u32x4){lo_.x, lo_.y, hi_.x, hi_.y}; })
#define SC_ISSUE(c) do { const size_t gi = (tok0 + (size_t)(c) * SC_T + s) * CM + h * 64 + seg * 4; \
            rR = SC_LD2(R); rK = SC_LD2(Kx); rE = SC_LD2(E); rA = SC_LD2(A); \
            if (lt < 64) rV = *(const u32x4*)(V + (tok0 + (size_t)(c) * SC_T + s2) * CM + h * 64 + 16 * q + half * 8); } while (0)
#define SC_PREP(bufi) do { float* Bf = sm + (bufi) * SC_BUF; \
            float kf[8], af[8], ef[8], rf[8], kkr[8]; \
            _Pragma("unroll") for (int j = 0; j < 4; ++j) { \
                kf[2 * j] = h2f(rK[j] & 0xffffu); kf[2 * j + 1] = h2f(rK[j] >> 16); af[2 * j] = h2f(rA[j] & 0xffffu); af[2 * j + 1] = h2f(rA[j] >> 16); \
                ef[2 * j] = h2f(rE[j] & 0xffffu); ef[2 * j + 1] = h2f(rE[j] >> 16); rf[2 * j] = h2f(rR[j] & 0xffffu); rf[2 * j + 1] = h2f(rR[j] >> 16); } \
            float ssq = 0.f; \
            _Pragma("unroll") for (int j = 0; j < 8; ++j) { kkr[j] = kf[j] * kkw[j]; ssq += kkr[j] * kkr[j]; } \
            ssq = sum8(ssq); const float inv = rsqrtf(fmaxf(ssq, 1e-24f)); \
            f32x4 w0, w1, p0, p1, n0, n1, b0, b1, r0, r1; \
            _Pragma("unroll") for (int j = 0; j < 4; ++j) { \
                const float kA = kkr[j] * inv, kB = kkr[j + 4] * inv; \
                w0[j] = __expf(-ef[j]); w1[j] = __expf(-ef[j + 4]); \
                p0[j] = kf[j] * (1.0f + (af[j] - 1.0f) * kaw[j]); p1[j] = kf[j + 4] * (1.0f + (af[j + 4] - 1.0f) * kaw[j + 4]); \
                n0[j] = kA; n1[j] = kB; b0[j] = kA * af[j]; b1[j] = kB * af[j + 4]; r0[j] = rf[j]; r1[j] = rf[j + 4]; } \
            const int ix = s * 64 + seg * 4; \
            *(f32x4*)(Bf + ix) = w0; *(f32x4*)(Bf + ix + 32) = w1; *(f32x4*)(Bf + 2048 + ix) = p0; *(f32x4*)(Bf + 2048 + ix + 32) = p1; \
            *(f32x4*)(Bf + 4096 + ix) = n0; *(f32x4*)(Bf + 4096 + ix + 32) = n1; *(f32x4*)(Bf + 6144 + ix) = b0; *(f32x4*)(Bf + 6144 + ix + 32) = b1; \
            *(f32x4*)(Bf + 8192 + ix) = r0; *(f32x4*)(Bf + 8192 + ix + 32) = r1; \
            if (lt < 64) { f32x4 v0, v1; \
                _Pragma("unroll") for (int j = 0; j < 2; ++j) { v0[2 * j] = h2f(rV[j] & 0xffffu); v0[2 * j + 1] = h2f(rV[j] >> 16); v1[2 * j] = h2f(rV[j + 2] & 0xffffu); v1[2 * j + 1] = h2f(rV[j + 2] >> 16); } \
                *(f32x4*)(Bf + 10240 + s2 * 16 + half * 8) = v0; *(f32x4*)(Bf + 10240 + s2 * 16 + half * 8 + 4) = v1; } } while (0)
#define SC_YOUT(c) do { const float* ypb = sm + SC_Y + ((c) & 1) * SC_YSZ; \
            _Pragma("unroll") for (int o = 0; o < 2; ++o) { const int oi = lt + 256 * o; const float* qp = ypb + oi * 17; \
                const float a0 = (qp[0] + qp[1]) + (qp[2] + qp[3]), a1 = (qp[4] + qp[5]) + (qp[6] + qp[7]), a2 = (qp[8] + qp[9]) + (qp[10] + qp[11]), a3 = (qp[12] + qp[13]) + (qp[14] + qp[15]); \
                const float yv = (a0 + a1) + (a2 + a3); \
                Y[(tok0 + (size_t)(c) * SC_T + (oi >> 4)) * CM + h * 64 + 16 * q + (oi & 15)] = (u16)(cvt_pk_bf16(yv, yv) & 0xffffu); } } while (0)
            SC_ISSUE(0);
            SC_PREP(0);
            SC_ISSUE(1);
            __syncthreads();
            for (int c = 0; c < nchunk; ++c) {
                if (c > 0) SC_YOUT(c - 1);
                if (c + 1 < nchunk) { SC_PREP((c + 1) & 1); if (c + 2 < nchunk) SC_ISSUE(c + 2); }
                __syncthreads();
            }
            SC_YOUT(nchunk - 1);
#undef SC_ISSUE
#undef SC_LD2
#undef SC_PREP
#undef SC_YOUT
        } else {
            const int c4 = lane & 15, rl = wave * 4 + (lane >> 4);
            f32x2 Sa = {0.f, 0.f}, Sb = {0.f, 0.f};
            __builtin_amdgcn_s_setprio(3);
            __syncthreads();
#define SC_LD(P, s_) do { w##P = *(const f32x4*)(Bo + (s_) * 64); k##P = *(const f32x4*)(Bo + 2048 + (s_) * 64); n##P = *(const f32x4*)(Bo + 4096 + (s_) * 64); \
            b##P = *(const f32x4*)(Bo + 6144 + (s_) * 64); r##P = *(const f32x4*)(Bo + 8192 + (s_) * 64); v##P = Vo[(s_) * 16]; } while (0)
#define SC_STEP(P, s_) do { \
            const f32x2 n01 = {n##P[0], n##P[1]}, n23 = {n##P[2], n##P[3]}, w01 = {w##P[0], w##P[1]}, w23 = {w##P[2], w##P[3]}; \
            const f32x2 k01 = {k##P[0], k##P[1]}, k23 = {k##P[2], k##P[3]}, b01 = {b##P[0], b##P[1]}, b23 = {b##P[2], b##P[3]}; \
            const f32x2 r01 = {r##P[0], r##P[1]}, r23 = {r##P[2], r##P[3]}; \
            f32x2 dd = Sa * n01; dd = Sb * n23 + dd; \
            float d = dd.x + dd.y; d = sum16(d); \
            const f32x2 vv = {v##P, v##P}; \
            f32x2 t0 = vv * k01; t0 = Sa * w01 + t0; f32x2 t1 = vv * k23; t1 = Sb * w23 + t1; \
            const f32x2 d2 = {d, d}; \
            Sa = t0 - d2 * b01; Sb = t1 - d2 * b23; \
            f32x2 yy = Sa * r01; yy = Sb * r23 + yy; \
            yo[(s_) * 272] = yy.x + yy.y; } while (0)
            for (int c = 0; c < nchunk; ++c) {
                const float* Bo = sm + (c & 1) * SC_BUF + c4 * 4;
                const float* Vo = sm + (c & 1) * SC_BUF + 10240 + rl;
                float* yo = sm + SC_Y + (c & 1) * SC_YSZ + rl * 17 + c4;
                f32x4 wA, kA, nA, bA, rA, wB, kB, nB, bB, rB, wC, kC, nC, bC, rC, wD, kD, nD, bD, rD; float vA, vB, vC, vD;
                SC_LD(A, 0); SC_LD(B, 1);
#pragma unroll
                for (int s = 0; s < SC_T; s += 4) {
                    SC_LD(C, s + 2);
                    SC_STEP(A, s);
                    SC_LD(D, s + 3);
                    SC_STEP(B, s + 1);
                    SC_LD(A, (s + 4 < SC_T) ? s + 4 : SC_T - 1);
                    SC_STEP(C, s + 2);
                    SC_LD(B, (s + 5 < SC_T) ? s + 5 : SC_T - 1);
                    SC_STEP(D, s + 3);
                }
                __syncthreads();
            }
#undef SC_LD
#undef SC_STEP
            __builtin_amdgcn_s_setprio(0);
        }
    }
}

struct PostRow { u32x4 yv[2], rv[2], kv[2], vv[2], av[2], gv[2]; };
__device__ __forceinline__ void post_load(PostRow& q, const u16* Y, const u16* R, const u16* Kx, const u16* V, const u16* A, const u16* Gt, size_t off) {
#pragma unroll
    for (int i = 0; i < 2; ++i) { q.yv[i] = *(const u32x4*)(Y + off + 8 * i); q.rv[i] = *(const u32x4*)(R + off + 8 * i); q.kv[i] = *(const u32x4*)(Kx + off + 8 * i);
        q.vv[i] = *(const u32x4*)(V + off + 8 * i); q.av[i] = *(const u32x4*)(A + off + 8 * i); q.gv[i] = *(const u32x4*)(Gt + off + 8 * i); }
}
__device__ __forceinline__ void post_row(const PostRow& q, const float (&lg)[16], const float (&lb)[16], const float (&ka)[16], const float (&rk)[16], u16* Y, size_t off) {
    float y[16], sum = 0.f, bon = 0.f;
#pragma unroll
    for (int j = 0; j < 16; ++j) {
        const unsigned wy = q.yv[j >> 3][(j >> 1) & 3], wr_ = q.rv[j >> 3][(j >> 1) & 3], wk = q.kv[j >> 3][(j >> 1) & 3], wa = q.av[j >> 3][(j >> 1) & 3];
        const unsigned sh = (j & 1) * 16;
        y[j] = bf2f((wy >> sh) & 0xffffu); sum += y[j];
        const float r = h2f((wr_ >> sh) & 0xffffu), k = h2f((wk >> sh) & 0xffffu), a = h2f((wa >> sh) & 0xffffu);
        bon += r * (k * (1.0f + (a - 1.0f) * ka[j])) * rk[j];
    }
    sum = sum4(sum); bon = sum4(bon);
    const float mean = sum * (1.0f / 64.0f);
    float var = 0.f;
#pragma unroll
    for (int j = 0; j < 16; ++j) { const float d = y[j] - mean; var += d * d; }
    var = sum4(var) * (1.0f / 64.0f);
    const float rstd = rsqrtf(var + 64e-5f);
    float o[16];
#pragma unroll
    for (int j = 0; j < 16; ++j) {
        const unsigned wv = q.vv[j >> 3][(j >> 1) & 3], wg = q.gv[j >> 3][(j >> 1) & 3]; const unsigned sh = (j & 1) * 16;
        const float v = h2f((wv >> sh) & 0xffffu), g = bf2f((wg >> sh) & 0xffffu);
        o[j] = ((y[j] - mean) * rstd * lg[j] + lb[j] + bon * v) * g;
    }
#pragma unroll
    for (int i = 0; i < 2; ++i) { u32x4 w; w.x = cvt_pk_bf16(o[8 * i], o[8 * i + 1]); w.y = cvt_pk_bf16(o[8 * i + 2], o[8 * i + 3]); w.z = cvt_pk_bf16(o[8 * i + 4], o[8 * i + 5]); w.w = cvt_pk_bf16(o[8 * i + 6], o[8 * i + 7]);
        *(u32x4*)(Y + off + 8 * i) = w; }
}
__device__ __forceinline__ void post_phase(u16* Y, const u16* __restrict__ R, const u16* __restrict__ Kx, const u16* __restrict__ V,
                                           const u16* __restrict__ A, const u16* __restrict__ Gt, const float* __restrict__ ln_g, const float* __restrict__ ln_b,
                                           const float* __restrict__ k_a, const float* __restrict__ r_k) {
    const int tid_ = otid(); const int wave = tid_ >> 6, lane = tid_ & 63, ch0 = lane * 16;
    float lg[16], lb[16], ka[16], rk[16];
#pragma unroll
    for (int j = 0; j < 16; ++j) { lg[j] = ln_g[ch0 + j]; lb[j] = ln_b[ch0 + j]; ka[j] = k_a[ch0 + j]; rk[j] = r_k[ch0 + j]; }
    const int stride = gridDim.x * 8;
    for (int row = blockIdx.x * 8 + wave; row < MTOK; row += 2 * stride) {
        const size_t off0 = (size_t)row * CM + ch0, off1 = (size_t)(row + stride) * CM + ch0;
        const bool two = (row + stride) < MTOK;
        PostRow q0, q1;
        post_load(q0, Y, R, Kx, V, A, Gt, off0);
        if (two) post_load(q1, Y, R, Kx, V, A, Gt, off1);
        post_row(q0, lg, lb, ka, rk, Y, off0);
        if (two) post_row(q1, lg, lb, ka, rk, Y, off1);
    }
}

__device__ __forceinline__ void headnorm_phase(u16* __restrict__ Hb, const float* __restrict__ gain, float scale) {
    const int tid_ = otid(); const int wave = tid_ >> 6, lane = tid_ & 63, ch0 = lane * 16;
    float gn[16];
#pragma unroll
    for (int j = 0; j < 16; ++j) gn[j] = gain[(ch0 + j) & 63] * scale;
    for (int row = blockIdx.x * 8 + wave; row < MTOK; row += gridDim.x * 8) {
        const size_t off = (size_t)row * CM + ch0;
        u32x4 xv[2]; xv[0] = *(const u32x4*)(Hb + off); xv[1] = *(const u32x4*)(Hb + off + 8);
        float x[16], ss = 0.f;
#pragma unroll
        for (int j = 0; j < 16; ++j) { const unsigned w = xv[j >> 3][(j >> 1) & 3]; x[j] = bf2f((w >> ((j & 1) * 16)) & 0xffffu); ss += x[j] * x[j]; }
        ss = sum4(ss);
        const float r = rsqrtf(ss * (1.0f / 64.0f) + 1e-6f);
#pragma unroll
        for (int i = 0; i < 2; ++i) { u32x4 w; w.x = cvt_pk_bf16(x[8 * i] * r * gn[8 * i], x[8 * i + 1] * r * gn[8 * i + 1]); w.y = cvt_pk_bf16(x[8 * i + 2] * r * gn[8 * i + 2], x[8 * i + 3] * r * gn[8 * i + 3]);
            w.z = cvt_pk_bf16(x[8 * i + 4] * r * gn[8 * i + 4], x[8 * i + 5] * r * gn[8 * i + 5]); w.w = cvt_pk_bf16(x[8 * i + 6] * r * gn[8 * i + 6], x[8 * i + 7] * r * gn[8 * i + 7]);
            *(u32x4*)(Hb + off + 8 * i) = w; }
    }
}

__device__ __forceinline__ void vt_phase(const u16* __restrict__ Vr, u16* __restrict__ VT, u16* ts) {
    const int tid = otid();
    constexpr int PITCH = 66;
    for (int unit = blockIdx.x; unit < NB * 8 * (TT / 64); unit += gridDim.x) {
        const int tt = unit & 127, h = (unit >> 7) & 7, b = unit >> 10, t0 = tt * 64;
        {
            const int tok = tid >> 3, seg = tid & 7;
            const u16* src = Vr + ((size_t)b * TT + t0 + tok) * CM + h * 128 + seg * 16;
            const u32x4 a = *(const u32x4*)src, c = *(const u32x4*)(src + 8);
#pragma unroll
            for (int j = 0; j < 4; ++j) {
                ts[(seg * 16 + 2 * j) * PITCH + tok] = (u16)(a[j] & 0xffffu); ts[(seg * 16 + 2 * j + 1) * PITCH + tok] = (u16)(a[j] >> 16);
                ts[(seg * 16 + 8 + 2 * j) * PITCH + tok] = (u16)(c[j] & 0xffffu); ts[(seg * 16 + 8 + 2 * j + 1) * PITCH + tok] = (u16)(c[j] >> 16);
            }
        }
        __syncthreads();
        {
            const int d = tid >> 2, sg = tid & 3;
            const unsigned* rowp = (const unsigned*)(ts + d * PITCH + sg * 16);
            u32x4 a, c;
            a.x = rowp[0]; a.y = rowp[1]; a.z = rowp[2]; a.w = rowp[3]; c.x = rowp[4]; c.y = rowp[5]; c.z = rowp[6]; c.w = rowp[7];
            u16* dst = VT + ((((size_t)b * 8 + h) * 128 + tt) * 128 + d) * 64 + sg * 16;
            *(u32x4*)dst = a; *(u32x4*)(dst + 8) = c;
        }
        __syncthreads();
    }
}

constexpr int AT_KP = 288, AT_VP = 160, AT_KB = 64 * AT_KP, AT_VB = 128 * AT_VP, AT_BUF = AT_KB + AT_VB;
template <bool DIAG> __device__ __forceinline__ void att_softmax(f32x4 (&st)[4], float& mrow, float& pend, f32x4 (&o)[8], f32x4& lacc, bf16x8 (&pb)[2], int kv0, int quad, int qidx) {
    if (DIAG) {
#pragma unroll
        for (int kb = 0; kb < 4; ++kb)
#pragma unroll
            for (int r = 0; r < 4; ++r) if (kv0 + kb * 16 + quad * 4 + r > qidx) st[kb][r] = -INFINITY;
    }
    float mxa = fmaxf(fmaxf(st[0][0], st[0][1]), st[0][2]), mxb = fmaxf(fmaxf(st[2][0], st[2][1]), st[2][2]);
    mxa = fmaxf(fmaxf(mxa, st[0][3]), st[1][0]); mxb = fmaxf(fmaxf(mxb, st[2][3]), st[3][0]);
    mxa = fmaxf(fmaxf(mxa, st[1][1]), st[1][2]); mxb = fmaxf(fmaxf(mxb, st[3][1]), st[3][2]);
    float mx = fmaxf(fmaxf(mxa, st[1][3]), fmaxf(mxb, st[3][3]));
    float mcmp;
    if (DIAG) { mx = fmaxf(mx, __shfl_xor(mx, 16)); mx = fmaxf(mx, __shfl_xor(mx, 32)); mcmp = mx; }
    else mcmp = pend;
    if (__any(mcmp > mrow)) {
        const float mnew = fmaxf(mrow, mcmp);
        const float alpha = __builtin_amdgcn_exp2f(mrow - mnew);
        mrow = mnew;
#pragma unroll
        for (int db = 0; db < 8; ++db) o[db] = o[db] * alpha;
        lacc = lacc * alpha;
    }
    float ex1 = 0.f;
    if (!DIAG) ex1 = fmaxf(mx, __shfl_xor(mx, 16));
    const f32x2 m2 = {mrow, mrow};
#pragma unroll
    for (int kb = 0; kb < 4; ++kb) {
        const f32x2 d0 = (f32x2){st[kb][0], st[kb][1]} - m2, d1 = (f32x2){st[kb][2], st[kb][3]} - m2;
        st[kb][0] = __builtin_amdgcn_exp2f(d0.x); st[kb][1] = __builtin_amdgcn_exp2f(d0.y); st[kb][2] = __builtin_amdgcn_exp2f(d1.x); st[kb][3] = __builtin_amdgcn_exp2f(d1.y);
    }
#pragma unroll
    for (int kp = 0; kp < 2; ++kp) {
        u32x4 w;
        w.x = cvt_pk_bf16(st[2 * kp][0], st[2 * kp][1]); w.y = cvt_pk_bf16(st[2 * kp][2], st[2 * kp][3]);
        w.z = cvt_pk_bf16(st[2 * kp + 1][0], st[2 * kp + 1][1]); w.w = cvt_pk_bf16(st[2 * kp + 1][2], st[2 * kp + 1][3]);
        pb[kp] = __builtin_bit_cast(bf16x8, w);
    }
    if (!DIAG) pend = fmaxf(ex1, __shfl_xor(ex1, 32)); else pend = mrow;
}
template <bool DIAG> __device__ __forceinline__ void att_tile(const LAS unsigned char* Ks, const LAS unsigned char* Vs, const bf16x8 (&bq)[2][2], f32x4 (&o)[2][8], f32x4 (&lacc)[2], float (&mrow)[2], float (&pend)[2],
                                                          float bbase, float slope2, int kv0, int lr, int quad, int qidx, const bf16x8& ones) {
    f32x4 st[2][4];
#pragma unroll
    for (int kb = 0; kb < 4; ++kb) {
        f32x4 bias;
#pragma unroll
        for (int r = 0; r < 4; ++r) bias[r] = bbase + slope2 * (float)(kb * 16 + r);
#pragma unroll
        for (int c = 0; c < 2; ++c) {
            const LAS unsigned char* kp = Ks + (kb * 16 + lr) * AT_KP + (c * 64 + quad * 8) * 2;
            const bf16x8 a0 = *(const LAS bf16x8*)kp, a1 = *(const LAS bf16x8*)(kp + 64);
            f32x4 z = __builtin_amdgcn_mfma_f32_16x16x32_bf16(a0, bq[c][0], bias, 0, 0, 0);
            st[c][kb] = __builtin_amdgcn_mfma_f32_16x16x32_bf16(a1, bq[c][1], z, 0, 0, 0);
        }
        if (kb == 1) __builtin_amdgcn_sched_barrier(0);
    }
    bf16x8 pb[2][2];
    att_softmax<DIAG>(st[0], mrow[0], pend[0], o[0], lacc[0], pb[0], kv0, quad, qidx);
    att_softmax<DIAG>(st[1], mrow[1], pend[1], o[1], lacc[1], pb[1], kv0, quad, qidx);
#pragma unroll
    for (int kp = 0; kp < 2; ++kp) {
        lacc[0] = __builtin_amdgcn_mfma_f32_16x16x32_bf16(ones, pb[0][kp], lacc[0], 0, 0, 0);
        lacc[1] = __builtin_amdgcn_mfma_f32_16x16x32_bf16(ones, pb[1][kp], lacc[1], 0, 0, 0);
    }
#pragma unroll
    for (int db = 0; db < 8; ++db)
#pragma unroll
        for (int kp = 0; kp < 2; ++kp) {
            const bf16x8 vf = *(const LAS bf16x8*)(Vs + (db * 16 + lr) * AT_VP + (kp * 32 + quad * 8) * 2);
            o[0][db] = __builtin_amdgcn_mfma_f32_16x16x32_bf16(vf, pb[0][kp], o[0][db], 0, 0, 0);
            o[1][db] = __builtin_amdgcn_mfma_f32_16x16x32_bf16(vf, pb[1][kp], o[1][db], 0, 0, 0);
        }
}
__device__ __forceinline__ void attn_phase(const u16* __restrict__ Q, const u16* __restrict__ Kn, const u16* __restrict__ VT, u16* __restrict__ O,
                                           const float* __restrict__ q_norm, const float* __restrict__ k_norm, const float* __restrict__ lam,
                                           const float* __restrict__ subln, unsigned char* sm) {
    const int tid = otid(), wave = tid >> 6, lane = tid & 63, lr = lane & 15, quad = lane >> 4;
    const int G = (int)gridDim.x, bid = (int)blockIdx.x;
    float lam_full, thr;
    {
        const float l0 = lam[lane] * lam[64 + lane], l1 = lam[128 + lane] * lam[192 + lane];
        lam_full = __expf(wave_sum(l0)) - __expf(wave_sum(l1)) + LAM_INIT1;
        const float gq = wave_max(fabsf(q_norm[lane])), gk = wave_max(fabsf(k_norm[lane]));
        thr = 2.0f * (8.0f * gq * gk) + 30.0f;
    }
    const u32x4 onesw = {0x3F803F80u, 0x3F803F80u, 0x3F803F80u, 0x3F803F80u};
    const bf16x8 ones = __builtin_bit_cast(bf16x8, onesw);
    const int nunits = NB * 8 * (TT / 128);
    if (__builtin_amdgcn_readfirstlane(tid) >= 256) __builtin_amdgcn_s_setprio(1);
    for (int rr = 0;; ++rr) {
        const int pos = rr * G + ((rr & 1) ? (G - 1 - bid) : bid);
        if (rr * G >= nunits) break;
        if (pos >= nunits) continue;
        const int b = pos & 3, qt = 63 - ((pos >> 2) & 63), h = 7 - (pos >> 8);
        const int q0 = qt * 128;
        const float slope = __builtin_amdgcn_exp2f(-(float)(h + 1));
        const float slope2 = slope * LOG2E;
        int Wi = (int)(thr / slope) + 1; if (Wi > TT) Wi = TT;
        int kvs = q0 - Wi; if (kvs < 0) kvs = 0; kvs &= ~63;
        const int ntile = (q0 + 128 - kvs) >> 6;
        const size_t tokb = (size_t)b * TT;
        const int qidx = q0 + wave * 16 + lr;
        bf16x8 bq[2][2];
#pragma unroll
        for (int c = 0; c < 2; ++c) {
            u32x4 raw[2]; float qf[16], ss = 0.f;
#pragma unroll
            for (int kk = 0; kk < 2; ++kk) raw[kk] = *(const u32x4*)(Q + (tokb + qidx) * CM + h * 128 + c * 64 + kk * 32 + quad * 8);
#pragma unroll
            for (int j = 0; j < 16; ++j) { const unsigned w = raw[j >> 3][(j >> 1) & 3]; qf[j] = bf2f((w >> ((j & 1) * 16)) & 0xffffu); ss += qf[j] * qf[j]; }
            ss += __shfl_xor(ss, 16); ss += __shfl_xor(ss, 32);
            const float rq = rsqrtf(ss * (1.0f / 64.0f) + 1e-6f) * (0.125f * LOG2E);
#pragma unroll
            for (int kk = 0; kk < 2; ++kk) {
                const f32x4 g0 = *(const f32x4*)(q_norm + kk * 32 + quad * 8), g1 = *(const f32x4*)(q_norm + kk * 32 + quad * 8 + 4);
                u32x4 w;
                w.x = cvt_pk_bf16(qf[8 * kk + 0] * rq * g0[0], qf[8 * kk + 1] * rq * g0[1]); w.y = cvt_pk_bf16(qf[8 * kk + 2] * rq * g0[2], qf[8 * kk + 3] * rq * g0[3]);
                w.z = cvt_pk_bf16(qf[8 * kk + 4] * rq * g1[0], qf[8 * kk + 5] * rq * g1[1]); w.w = cvt_pk_bf16(qf[8 * kk + 6] * rq * g1[2], qf[8 * kk + 7] * rq * g1[3]);
                bq[c][kk] = __builtin_bit_cast(bf16x8, w);
            }
        }
        f32x4 o[2][8], lacc[2];
#pragma unroll
        for (int c = 0; c < 2; ++c) {
            lacc[c] = (f32x4){0.f, 0.f, 0.f, 0.f};
#pragma unroll
            for (int db = 0; db < 8; ++db) o[c][db] = (f32x4){0.f, 0.f, 0.f, 0.f};
        }
        float mrow[2] = {-1e30f, -1e30f}, pend[2] = {-1e30f, -1e30f};
        u32x4 kregA[2], vregA[2], kregB[2], vregB[2];
        const u16* kbase = Kn + ((size_t)b * 8 + h) * 128 * 8192 + tid * 8;
        const u16* vbase = VT + ((size_t)b * 8 + h) * 128 * 8192 + tid * 8;
#define AT_LOAD(P, kv0) do { _Pragma("unroll") for (int i = 0; i < 2; ++i) { \
            kreg##P[i] = *(const u32x4*)(kbase + (size_t)((kv0) >> 6) * 8192 + 4096 * i); \
            vreg##P[i] = *(const u32x4*)(vbase + (size_t)((kv0) >> 6) * 8192 + 4096 * i); } } while (0)
#define AT_STORE(P, bufi) do { unsigned char* bb = sm + (bufi) * AT_BUF; _Pragma("unroll") for (int i = 0; i < 2; ++i) { const int pc = tid + 512 * i; \
            *(u32x4*)(bb + (pc >> 4) * AT_KP + (pc & 15) * 16) = kreg##P[i]; \
            const int sg = pc & 7, k0 = (sg & 3) * 8, ps = (sg >> 2) * 32 + ((k0 & 15) >> 2) * 8 + (k0 >> 4) * 4; \
            unsigned char* vp = bb + AT_KB + (pc >> 3) * AT_VP + ps * 2; \
            *(u32x2*)vp = (u32x2){vreg##P[i].x, vreg##P[i].y}; *(u32x2*)(vp + 16) = (u32x2){vreg##P[i].z, vreg##P[i].w}; } } while (0)
#define AT_COMPUTE(idx_) do { const int kv0 = kvs + (ntile - 1 - (idx_)) * 64; \
            if (kv0 <= q0 + wave * 16 + 15) { const LAS unsigned char* Ks = (const LAS unsigned char*)sm + ((idx_) & 1) * AT_BUF; \
                const float bbase = slope2 * (float)(kv0 + quad * 4 - q0); \
                if (kv0 + 63 > q0 + wave * 16) att_tile<true>(Ks, Ks + AT_KB, bq, o, lacc, mrow, pend, bbase, slope2, kv0, lr, quad, qidx, ones); \
                else att_tile<false>(Ks, Ks + AT_KB, bq, o, lacc, mrow, pend, bbase, slope2, kv0, lr, quad, qidx, ones); } } while (0)
        const int kvtop = kvs + (ntile - 1) * 64;
        __syncthreads();
        AT_LOAD(A, kvtop); AT_STORE(A, 0);
        AT_LOAD(A, kvtop - 64);
        if (ntile > 2) AT_LOAD(B, kvtop - 128);
        __syncthreads();
        for (int idx = 0; idx < ntile; idx += 2) {
            AT_COMPUTE(idx);
            if (idx + 1 < ntile) { AT_STORE(A, 1); if (idx + 3 < ntile) AT_LOAD(A, kvtop - 64 * (idx + 3)); }
            __syncthreads();
            if (idx + 1 < ntile) {
                AT_COMPUTE(idx + 1);
                if (idx + 2 < ntile) { AT_STORE(B, 0); if (idx + 4 < ntile) AT_LOAD(B, kvtop - 64 * (idx + 4)); }
                __syncthreads();
            }
        }
#undef AT_COMPUTE
#undef AT_LOAD
#undef AT_STORE
        const float i0 = 1.0f / lacc[0][0], i1 = lam_full / lacc[1][0];
        float ss = 0.f;
#pragma unroll
        for (int db = 0; db < 8; ++db)
#pragma unroll
            for (int r = 0; r < 4; ++r) { const float v = o[0][db][r] * i0 - o[1][db][r] * i1; o[0][db][r] = v; ss += v * v; }
        ss += __shfl_xor(ss, 16); ss += __shfl_xor(ss, 32);
        const float rn = rsqrtf(ss * (1.0f / 128.0f) + 1e-5f) * (1.0f - LAM_INIT1);
        u16* op = O + (tokb + qidx) * CM + h * 128 + quad * 4;
#pragma unroll
        for (int db = 0; db < 8; ++db) {
            const f32x4 sb = *(const f32x4*)(subln + db * 16 + quad * 4);
            u32x2 w; w.x = cvt_pk_bf16(o[0][db][0] * rn * sb[0], o[0][db][1] * rn * sb[1]); w.y = cvt_pk_bf16(o[0][db][2] * rn * sb[2], o[0][db][3] * rn * sb[3]);
            *(u32x2*)(op + db * 16) = w;
        }
    }
    __builtin_amdgcn_s_setprio(0);
}

#define XB_TMO      128
#define XB_XCNT(j)  (256  + 64 * (j))
#define XB_XSUB(j)  (1280 + 64 * (j))
#define XB_XGEN(j)  (2304 + 64 * (j))
#define XB_TOP      3328
#define XB_TOPGEN   3392
#define XCD_BAR_WORDS 3456
#define XB_SPIN_CAP (1u << 18)
__device__ __forceinline__ unsigned xb_ld(unsigned* p)              { return __hip_atomic_load(p, __ATOMIC_RELAXED, __HIP_MEMORY_SCOPE_AGENT); }
__device__ __forceinline__ unsigned xb_add(unsigned* p, unsigned v) { return __hip_atomic_fetch_add(p, v, __ATOMIC_RELAXED, __HIP_MEMORY_SCOPE_AGENT); }
__device__ __forceinline__ unsigned xb_xcc_id() { return (unsigned)__builtin_amdgcn_s_getreg((3 << 11) | 20) & 0xFu; }
#define XB_SPIN(cond, bar) do { unsigned _sp = 0; while (cond) { __builtin_amdgcn_s_sleep(1); \
    if ((++_sp & 255u) == 0u) { if (xb_ld(&(bar)[XB_TMO])) break; if (_sp > XB_SPIN_CAP) { atomicAdd(&(bar)[XB_TMO], 1u); break; } } } } while (0)
struct XcdBarrier { unsigned* bar; unsigned x; volatile LAS unsigned* st; };
__device__ __forceinline__ XcdBarrier xcd_barrier_post(unsigned* bar, volatile LAS unsigned* st) {
    XcdBarrier b; b.bar = bar; b.x = xb_xcc_id(); b.st = st;
    if (threadIdx.x == 0) (void)xb_add(&bar[XB_XCNT(b.x)], 1u);
    return b;
}
__device__ __forceinline__ void xcd_barrier_complete(unsigned* bar, unsigned x, unsigned& nloc, unsigned& nx) {
    const unsigned G = gridDim.x * gridDim.y * gridDim.z;
    unsigned sum, cnt, mine, sp = 0u;
    for (;;) {
        sum = 0u; cnt = 0u; mine = 0u;
#pragma unroll
        for (unsigned j = 0; j < 16; ++j) { const unsigned c = xb_ld(&bar[XB_XCNT(j)]); sum += c; cnt += (c > 0u) ? 1u : 0u; mine = (j == x) ? c : mine; }
        if (sum == G) break;
        __builtin_amdgcn_s_sleep(1);
        if ((++sp & 255u) == 0u) { if (xb_ld(&bar[XB_TMO])) break; if (sp > XB_SPIN_CAP) { atomicAdd(&bar[XB_TMO], 1u); break; } }
    }
    nloc = mine > 0u ? mine : 1u; nx = cnt > 0u ? cnt : 1u;
}
__device__ __forceinline__ void xcd_barrier(const XcdBarrier& b) {
    asm volatile("s_waitcnt vmcnt(0)" ::: "memory");
    __syncthreads();
    if (threadIdx.x == 0) {
        unsigned* bar = b.bar;
        __builtin_amdgcn_s_waitcnt(0);
        unsigned nloc = b.st[0], nx = b.st[1];
        if (nloc == 0u) { xcd_barrier_complete(bar, b.x, nloc, nx); b.st[0] = nloc; b.st[1] = nx; }
        const unsigned old = xb_add(&bar[XB_XSUB(b.x)], 1u);
        const unsigned gen = old / nloc;
        if (old + 1u == (gen + 1u) * nloc) {
            __builtin_amdgcn_fence(__ATOMIC_RELEASE, "agent");
            asm volatile("s_waitcnt vmcnt(0)" ::: "memory");
            const unsigned og = xb_add(&bar[XB_TOP], 1u);
            const unsigned tg = og / nx;
            if (og + 1u == (tg + 1u) * nx) xb_add(&bar[XB_TOPGEN], 1u);
            else XB_SPIN(xb_ld(&bar[XB_TOPGEN]) == tg, bar);
            __builtin_amdgcn_fence(__ATOMIC_ACQUIRE, "agent");
            xb_add(&bar[XB_XGEN(b.x)], 1u);
            asm volatile("s_waitcnt vmcnt(0)" ::: "memory");
        } else {
            XB_SPIN(xb_ld(&bar[XB_XGEN(b.x)]) == gen, bar);
            __builtin_amdgcn_fence(__ATOMIC_ACQUIRE, "agent");
            asm volatile("s_waitcnt vmcnt(0)" ::: "memory");
        }
    }
    __syncthreads();
}

constexpr size_t WS_BAR = 0;
constexpr size_t WS_RSS = 65536;
constexpr size_t CTL_BYTES = WS_RSS + 5 * (size_t)MTOK * 4;
static_assert(CTL_BYTES <= 1 * MiB, "control region");
constexpr int LDS_ST_OFF = 159488;

__global__ void __launch_bounds__(NT, 2) yoco_fwd(Params p) {
    extern __shared__ __attribute__((aligned(16))) unsigned char lds[];
    cg::grid_group grid = cg::this_grid();
    LAS unsigned char* l3 = (LAS unsigned char*)lds;
    unsigned char* ws = p.ws;
    float* X = p.out;
    u16* S0 = (u16*)(ws + WS_S0); u16* S1 = (u16*)(ws + WS_S0 + SLOT); u16* S2 = (u16*)(ws + WS_S0 + 2 * SLOT);
    u16* S3 = (u16*)(ws + WS_S0 + 3 * SLOT); u16* S4 = (u16*)(ws + WS_S0 + 4 * SLOT); u16* S5 = (u16*)(ws + WS_S0 + 5 * SLOT);
    u16* LORA = (u16*)(ws + WS_LORA);
    float* RSS = (float*)(ws + WS_RSS);
    const size_t SLOT_E = SLOT / 2;
    constexpr int NOGRP = 1 << 20;
    volatile LAS unsigned* st = (volatile LAS unsigned*)(l3 + LDS_ST_OFF);
    if (threadIdx.x < 2) st[threadIdx.x] = 0u;
    __syncthreads();
    const XcdBarrier bar = xcd_barrier_post((unsigned*)(ws + WS_BAR), st);
#define SYNC() xcd_barrier(bar)
#define EPI(MODE, FMT, O_, ldc_, ss_, Xs_, Xd_, rs_, v0_, v1_, rss_, rso_, Xb_) pg8::Epi<pg8::MODE, FMT> e{O_, ldc_, ss_, Xs_, Xd_, rs_, v0_, v1_, rss_, rso_, Xb_, nullptr}
#define EPIR(Xs_, Xsb_, Xd_, Xb_, rs_, rso_) pg8::Epi<pg8::EM_RES, 0> e{nullptr, 0, 0, Xs_, Xd_, rs_, nullptr, nullptr, nullptr, rso_, Xb_, Xsb_}

    prep_phase(p, (float*)lds);
    cast_phase(p.in[0], S3, RSS);
    grid.sync();
    u16* XB = (u16*)p.out;
    { EPI(EM_SWIGLU, 0, S0, FF, 0, nullptr, nullptr, 0.f, nullptr, nullptr, RSS, nullptr, nullptr);
      run_gemm(l3, S3, CM, NOGRP, 0, (const u16*)(ws + WS_WIN), 2 * FF, CM, e); }
    SYNC();
    { EPIR(p.in[0], nullptr, nullptr, XB, 0.5f, nullptr);
      run_gemm(l3, S0, FF, NOGRP, 0, (const u16*)(ws + WS_WOUT), CM, FF, e); }
    SYNC();
    mix_phase(XB, p.in[4], p.in[5], S0, SLOT_E);
    SYNC();
    { EPI(EM_LORA1, 0, LORA, 384, 0, nullptr, nullptr, 0.f, nullptr, nullptr, nullptr, nullptr, nullptr);
      run_gemm(l3, S3, CM, 1, SLOT, (const u16*)(ws + WS_WL1), 768, CM, e); }
    SYNC();
    { EPI(EM_SPLIT, 1, S3, CM, SLOT_E, nullptr, nullptr, 0.f, nullptr, nullptr, nullptr, nullptr, nullptr);
      run_gemm(l3, S0, CM, 4, SLOT, (const u16*)(ws + WS_WRKV), 3 * CM, CM, e); }
    SYNC();
    { EPI(EM_LORA2, 1, S0, CM, SLOT_E, nullptr, nullptr, 0.f, p.in[7], p.in[10], nullptr, nullptr, nullptr);
      run_gemm(l3, LORA, 384, 4, 64 * 2, (const u16*)(ws + WS_WL2), 2 * CM, 256, e); }
    SYNC();
    scan_phase(S3, S4, S5, S0, S1, p.in[15], p.in[16], S2, (float*)lds);
    SYNC();
    { EPI(EM_SPLIT, 0, S0, CM, SLOT_E, nullptr, nullptr, 0.f, nullptr, nullptr, nullptr, nullptr, nullptr);
      run_gemm(l3, LORA + 128, 384, NOGRP, 0, (const u16*)(ws + WS_WG2), CM, 256, e); }
    SYNC();
    post_phase(S2, S3, S4, S5, S1, S0, p.in[18], p.in[19], p.in[16], p.in[17]);
    SYNC();
    { EPIR(nullptr, XB, nullptr, XB, 1.0f, RSS + MTOK);
      run_gemm(l3, S2, CM, NOGRP, 0, (const u16*)(ws + WS_WRO), CM, CM, e); }
    SYNC();
    { EPI(EM_SWIGLU, 0, S0, FF, 0, nullptr, nullptr, 0.f, nullptr, nullptr, RSS + MTOK, nullptr, nullptr);
      run_gemm(l3, XB, CM, NOGRP, 0, (const u16*)(ws + WS_WIN + WIN_SZ), 2 * FF, CM, e); }
    SYNC();
    { EPIR(nullptr, XB, nullptr, XB, 0.5f, RSS + 2 * MTOK);
      run_gemm(l3, S0, FF, NOGRP, 0, (const u16*)(ws + WS_WOUT + WOUT_SZ), CM, FF, e); }
    SYNC();
    { EPI(EM_SWIGLU, 0, S0, FF, 0, nullptr, nullptr, 0.f, nullptr, nullptr, RSS + 2 * MTOK, nullptr, nullptr);
      run_gemm(l3, XB, CM, NOGRP, 0, (const u16*)(ws + WS_WIN + 2 * WIN_SZ), 2 * FF, CM, e); }
    { EPI(EM_KV, 0, S4, CM, SLOT_E, nullptr, nullptr, 0.f, nullptr, nullptr, RSS + 2 * MTOK, nullptr, nullptr);
      run_gemm(l3, XB, CM, NOGRP, 0, (const u16*)(ws + WS_WKV), 2 * CM, CM, e); }
    SYNC();
    headnorm_phase(S4, p.in[23], 1.0f);
    vt_phase(S5, S3, (u16*)lds);
    { EPIR(nullptr, XB, nullptr, XB, 0.5f, RSS + 3 * MTOK);
      run_gemm(l3, S0, FF, NOGRP, 0, (const u16*)(ws + WS_WOUT + 2 * WOUT_SZ), CM, FF, e); }
    SYNC();
    { EPI(EM_SPLIT, 0, S0, CM, SLOT_E, nullptr, nullptr, 0.f, nullptr, nullptr, RSS + 3 * MTOK, nullptr, nullptr);
      run_gemm(l3, XB, CM, NOGRP, 0, (const u16*)(ws + WS_WQ), CM, CM, e); }
    SYNC();
    attn_phase(S0, S4, S3, S1, p.in[25], p.in[23], p.in[26], p.in[27], lds);
    SYNC();
    { EPIR(nullptr, XB, nullptr, S5, 1.0f, RSS + 4 * MTOK);
      run_gemm(l3, S1, CM, NOGRP, 0, (const u16*)(ws + WS_WDO), CM, CM, e); }
    SYNC();
    { EPI(EM_SWIGLU, 0, S0, FF, 0, nullptr, nullptr, 0.f, nullptr, nullptr, RSS + 4 * MTOK, nullptr, nullptr);
      run_gemm(l3, S5, CM, NOGRP, 0, (const u16*)(ws + WS_WIN + 3 * WIN_SZ), 2 * FF, CM, e); }
    SYNC();
    { EPIR(nullptr, S5, X, nullptr, 0.5f, nullptr);
      run_gemm(l3, S0, FF, NOGRP, 0, (const u16*)(ws + WS_WOUT + 3 * WOUT_SZ), CM, FF, e); }
#undef SYNC
#undef EPI
#undef EPIR
}

extern "C" void kernel_launch(void* const* d_in, const int* in_sizes, int n_in, void* d_out, int out_size, void* d_ws, size_t ws_size, hipStream_t stream) {
    static int grid_blocks = 0;
    if (grid_blocks == 0) {
        if (n_in != 29 || out_size != MTOK * CM || ws_size < WS_END) { fprintf(stderr, "kernel_launch: unexpected shapes (n_in %d out %d ws %zu)\n", n_in, out_size, ws_size); grid_blocks = -1; return; }
        int dev = 0, cus = 0, per_cu = 0;
        (void)hipGetDevice(&dev);
        (void)hipDeviceGetAttribute(&cus, hipDeviceAttributeMultiprocessorCount, dev);
        if (hipFuncSetAttribute((const void*)yoco_fwd, hipFuncAttributeMaxDynamicSharedMemorySize, LDS_BYTES) != hipSuccess) { fprintf(stderr, "hipFuncSetAttribute failed\n"); grid_blocks = -1; return; }
        if (hipOccupancyMaxActiveBlocksPerMultiprocessor(&per_cu, (const void*)yoco_fwd, NT, LDS_BYTES) != hipSuccess || per_cu < 1) { fprintf(stderr, "occupancy query failed (%d)\n", per_cu); per_cu = 1; }
        (void)hipGetLastError();
        grid_blocks = cus * per_cu;
        if (grid_blocks > 256) grid_blocks = 256;
    }
    if (grid_blocks < 0) return;
    (void)hipMemsetAsync((char*)d_ws, 0, CTL_BYTES, stream);
    Params p{};
    for (int i = 0; i < 29; ++i) p.in[i] = (const float*)d_in[i];
    p.out = (float*)d_out; p.ws = (unsigned char*)d_ws;
    void* args[] = {&p};
    hipError_t e = hipLaunchCooperativeKernel((const void*)yoco_fwd, dim3(grid_blocks), dim3(NT), args, LDS_BYTES, stream);
    if (e != hipSuccess) fprintf(stderr, "cooperative launch failed: %s (grid %d)\n", hipGetErrorString(e), grid_blocks);
}
```

```cpp
#include <hip/hip_runtime.h>
#include <hip/hip_cooperative_groups.h>
#include <cstdio>
#include <cstdint>
namespace cg = cooperative_groups;

namespace pg8 {
#define PG8_LAS __attribute__((address_space(3)))
typedef unsigned short bf16_t;
typedef short bf16x8 __attribute__((ext_vector_type(8)));
typedef float f32x4 __attribute__((ext_vector_type(4)));
typedef unsigned u32x4 __attribute__((ext_vector_type(4)));
constexpr int BM = 256, BK = 64, HALF = 128, HTB = HALF * BK * 2  , STAGE_BYTES = 8 * HTB, NXCD = 8, WGM = 8;

__host__ __device__ __forceinline__ int lds_byte(int r, int c) { const int st = (r >> 4) * 2 + (c >> 5), rr = r & 15, cc = c & 31, ob = rr * 64 + cc * 2; return st * 1024 + (ob ^ (((ob >> 9) & 1) << 5)); }
__host__ __device__ __forceinline__ void stage_rc(int b, int& R, int& C) { const int st = b / 1024, sb = b % 1024, swz = sb ^ (((sb >> 9) & 1) << 5); R = (st >> 1) * 16 + swz / 64; C = (st & 1) * 32 + (swz % 64) / 2; }
__host__ __device__ __forceinline__ int perm32(int rho) { const int n = rho >> 4, i = rho & 15; return 8 * (i >> 2) + 4 * n + (i & 3); }

struct Unit { int pm, pn; };
struct Gemm { const bf16_t* A; const bf16_t* Bt; int M, N, K; int lda; int agc; size_t ags; };

struct StaticOrder {
    int nM, nN, nwg, G, c;
    __host__ __device__ void init(int M, int N, int G_, int c_) { nM = M / BM; nN = N / BM; nwg = nM * nN; G = G_; c = c_; }
    __host__ __device__ bool next(int i, Unit& u) const {
        const long L = (long)i * G + c; if (L >= nwg) return false;
        int wgid = (int)L; { const int q = nwg / NXCD, r = nwg % NXCD, xcd = wgid % NXCD, off = wgid / NXCD; wgid = (xcd < r ? xcd * (q + 1) : r * (q + 1) + (xcd - r) * q) + off; }
        const int nig = WGM * nN, gid = wgid / nig, fm = gid * WGM, gsz = (nM - fm) < WGM ? (nM - fm) : WGM;
        u.pm = fm + ((wgid % nig) % gsz); u.pn = (wgid % nig) / gsz; return true;
    }
    __device__ __forceinline__ void a_ready(const Unit&) const {}
    __device__ __forceinline__ void done(const Unit&) const {}
};

__device__ __forceinline__ unsigned cvt_pk_bf16(float lo, float hi) { unsigned r; asm volatile("v_cvt_pk_bf16_f32 %0, %1, %2" : "=v"(r) : "v"(lo), "v"(hi)); return r; }

__device__ __forceinline__ unsigned pk_f16(float lo, float hi) {
    _Float16 a = (_Float16)lo, b = (_Float16)hi;
    return (unsigned)__builtin_bit_cast(unsigned short, a) | ((unsigned)__builtin_bit_cast(unsigned short, b) << 16);
}
__device__ __forceinline__ float fast_sigmoid(float x) { return __builtin_amdgcn_rcpf(1.0f + __expf(-x)); }
__device__ __forceinline__ float fast_tanh(float x) { return 1.0f - 2.0f * __builtin_amdgcn_rcpf(1.0f + __expf(2.0f * x)); }
template <int FMT> __device__ __forceinline__ u32x4 pack8(const f32x4& v0, const f32x4& v1) {
    u32x4 w;
    if (FMT == 0) { w.x = cvt_pk_bf16(v0[0], v0[1]); w.y = cvt_pk_bf16(v0[2], v0[3]); w.z = cvt_pk_bf16(v1[0], v1[1]); w.w = cvt_pk_bf16(v1[2], v1[3]); }
    else { w.x = pk_f16(v0[0], v0[1]); w.y = pk_f16(v0[2], v0[3]); w.z = pk_f16(v1[0], v1[1]); w.w = pk_f16(v1[2], v1[3]); }
    return w;
}
enum { EM_SWIGLU = 0, EM_RES = 1, EM_SPLIT = 2, EM_LORA1 = 3, EM_LORA2 = 4, EM_KV = 5 };
template <int MODE, int FMT  > struct Epi {
    static constexpr bool PERM = true, AFTER_DRAIN = false;
    bf16_t* O; int ldc; size_t split_stride;
    const float* Xs; float* Xd; float rs;
    const float* v0; const float* v1;
    const float* rss;
    float* rso; bf16_t* Xb;
    const bf16_t* Xsb;
    __device__ __forceinline__ void operator()(const f32x4 (&acc)[2][2][4][2], const Unit& u, int wr, int wc, int fr, int fq) const {
        const int row0 = u.pm * BM + wr * 64 + fr;
        const int lc0 = wc * 32 + 8 * fq;
        float rsv[2][4]; u32x4 xin[2][4][2];
#pragma unroll
        for (int ai = 0; ai < 2; ++ai)
#pragma unroll
            for (int m = 0; m < 4; ++m) {
                const size_t row = (size_t)(row0 + ai * HALF + m * 16);
                rsv[ai][m] = 0.f;
                if constexpr (MODE == EM_SWIGLU || MODE == EM_SPLIT || MODE == EM_KV) { if (rss) rsv[ai][m] = rss[row]; }
                if constexpr (MODE == EM_RES) { if (!Xs) {
#pragma unroll
                    for (int bj = 0; bj < 2; ++bj) xin[ai][m][bj] = *(const u32x4*)(Xsb + row * 1024 + u.pn * BM + bj * HALF + lc0); } }
            }
#pragma unroll
        for (int ai = 0; ai < 2; ++ai)
#pragma unroll
            for (int m = 0; m < 4; ++m) {
                const size_t row = (size_t)(row0 + ai * HALF + m * 16);
                float rsc = 1.0f;
                if constexpr (MODE == EM_SWIGLU || MODE == EM_SPLIT || MODE == EM_KV) { if (rss) rsc = rsqrtf(rsv[ai][m] * (1.0f / 1024.0f) + 1e-6f); }
                float rsum = 0.f;
                if constexpr (MODE == EM_SWIGLU) {
                    const f32x4 ga = acc[ai][0][m][0], gb = acc[ai][0][m][1], ua = acc[ai][1][m][0], ub = acc[ai][1][m][1];
                    const float ce = -1.4426950408889634f * rsc, irs2 = 1.0f / (rsc * rsc);
                    f32x4 r0, r1;
#pragma unroll
                    for (int i = 0; i < 4; ++i) {
                        r0[i] = (ga[i] * ua[i]) * __builtin_amdgcn_rcpf(__builtin_amdgcn_exp2f(ga[i] * ce) * irs2 + irs2);
                        r1[i] = (gb[i] * ub[i]) * __builtin_amdgcn_rcpf(__builtin_amdgcn_exp2f(gb[i] * ce) * irs2 + irs2);
                    }
                    *(u32x4*)(O + row * ldc + u.pn * HALF + lc0) = pack8<0>(r0, r1);
                } else {
#pragma unroll
                    for (int bj = 0; bj < 2; ++bj) {
                        const int lc = bj * HALF + lc0;
                        f32x4 a0 = acc[ai][bj][m][0], a1 = acc[ai][bj][m][1];
                        if constexpr (MODE == EM_RES) {
                            const size_t off = row * 1024 + u.pn * BM + lc;
                            f32x4 x0, x1;
                            if (Xs) { x0 = *(const f32x4*)(Xs + off); x1 = *(const f32x4*)(Xs + off + 4); }
                            else { const u32x4 w = xin[ai][m][bj];
                                x0 = (f32x4){__builtin_bit_cast(float, w.x << 16), __builtin_bit_cast(float, w.x & 0xffff0000u), __builtin_bit_cast(float, w.y << 16), __builtin_bit_cast(float, w.y & 0xffff0000u)};
                                x1 = (f32x4){__builtin_bit_cast(float, w.z << 16), __builtin_bit_cast(float, w.z & 0xffff0000u), __builtin_bit_cast(float, w.w << 16), __builtin_bit_cast(float, w.w & 0xffff0000u)}; }
                            x0 = x0 + a0 * rs; x1 = x1 + a1 * rs;
                            if (Xd) { *(f32x4*)(Xd + off) = x0; *(f32x4*)(Xd + off + 4) = x1; }
                            if (Xb) *(u32x4*)(Xb + off) = pack8<0>(x0, x1);
                            if (rso) rsum += (x0[0] * x0[0] + x0[1] * x0[1]) + (x0[2] * x0[2] + x0[3] * x0[3]) + (x1[0] * x1[0] + x1[1] * x1[1]) + (x1[2] * x1[2] + x1[3] * x1[3]);
                        } else if constexpr (MODE == EM_SPLIT) {
                            const int t = u.pn >> 2, col = (u.pn & 3) * BM + lc;
                            *(u32x4*)(O + (size_t)t * split_stride + row * ldc + col) = pack8<FMT>(a0 * rsc, a1 * rsc);
                        } else if constexpr (MODE == EM_KV) {
                            const int t = u.pn >> 2, col = (u.pn & 3) * BM + lc;
                            if (t == 0) { const size_t rb = row >> 13, tt = row & 8191;
                                *(u32x4*)(O + ((((rb * 8 + (col >> 7)) * 128 + (tt >> 6)) * 64 + (tt & 63)) * 128 + (col & 127))) = pack8<0>(a0 * rsc, a1 * rsc); }
                            else *(u32x4*)(O + split_stride + row * ldc + col) = pack8<0>(a0 * rsc, a1 * rsc);
                        } else if constexpr (MODE == EM_LORA1) {
                            if (u.pn == 0) { if (lc < 64) { f32x4 r0, r1;
#pragma unroll
                                    for (int i = 0; i < 4; ++i) { r0[i] = fast_tanh(a0[i]); r1[i] = fast_tanh(a1[i]); }
                                    *(u32x4*)(O + row * ldc + lc) = pack8<0>(r0, r1); } }
                            else if (u.pn == 1) { if (lc < 64) *(u32x4*)(O + row * ldc + 64 + lc) = pack8<0>(a0, a1); }
                            else { f32x4 r0, r1;
#pragma unroll
                                for (int i = 0; i < 4; ++i) { r0[i] = fast_sigmoid(a0[i]); r1[i] = fast_sigmoid(a1[i]); }
                                *(u32x4*)(O + row * ldc + 128 + lc) = pack8<0>(r0, r1); }
                        } else if constexpr (MODE == EM_LORA2) {
                            const int t = u.pn >> 2, col = (u.pn & 3) * BM + lc;
                            const float* bv = t ? v1 : v0;
                            f32x4 b0 = *(const f32x4*)(bv + col), b1 = *(const f32x4*)(bv + col + 4), r0, r1;
                            const float sc = t ? 1.0f : 0.6065306597f;
#pragma unroll
                            for (int i = 0; i < 4; ++i) { r0[i] = sc * fast_sigmoid(a0[i] + b0[i]); r1[i] = sc * fast_sigmoid(a1[i] + b1[i]); }
                            *(u32x4*)(O + (size_t)t * split_stride + row * ldc + col) = pack8<1>(r0, r1);
                        }
                    }
                    if constexpr (MODE == EM_RES) { if (rso) { rsum += __shfl_xor(rsum, 16); rsum += __shfl_xor(rsum, 32); if (fq == 0) unsafeAtomicAdd(rso + row, rsum); } }
                }
            }
    }
};
template <class Epi, class Sched, bool ALIGN_EPI = false, bool SP2 = false>
__device__ __forceinline__ void gemm_phase(PG8_LAS unsigned char* lds, const Gemm g, const Sched& S, const Epi& E) {
    int tid = threadIdx.x; asm volatile("" : "+v"(tid)); const int wid = __builtin_amdgcn_readfirstlane(tid >> 6), lane = tid & 63, wr = wid >> 2, wc = wid & 3, fr = lane & 15, fq = lane >> 4;
    const int K = g.K, nt = K / BK;
    unsigned voffA[2], voffB[2];
#pragma unroll
    for (int i = 0; i < 2; ++i) { int R, C; stage_rc(tid * 16 + i * 8192, R, C); const int Rb = Epi::PERM ? ((R & ~31) + perm32(R & 31)) : R;
        voffA[i] = (unsigned)(R * g.lda + C) * 2u; voffB[i] = (unsigned)(Rb * K + C) * 2u; }
    const size_t kstep = (size_t)(BK * 2);
    const size_t hstepA = (size_t)HALF * g.lda * 2, hstepB = (size_t)HALF * K * 2;
    const size_t tstepA = 2 * hstepA, tstepB = 2 * hstepB;
    const unsigned ldsw = (unsigned)wid * 1024u;
    const int aoff = lds_byte(wr * 64 + fr, fq * 8), boff = lds_byte(wc * 32 + fr, fq * 8);
#define PG8_SA(b, h) (((b) * 2 + (h)) * HTB)
#define PG8_SB(b, h) ((4 + (b) * 2 + (h)) * HTB)
#define PG8_STAGE(bufoff, gbase, voff) do { _Pragma("unroll") for (int _i = 0; _i < 2; ++_i) \
        __builtin_amdgcn_global_load_lds((const unsigned*)((const char*)(gbase) + (voff)[_i]), (PG8_LAS unsigned*)(lds + (bufoff) + ldsw + _i * 8192), 16, 0, 0); } while (0)
#define PG8_LDA(dst, b, h) do { _Pragma("unroll") for (int m = 0; m < 4; ++m) _Pragma("unroll") for (int k = 0; k < 2; ++k) dst[m][k] = *(const PG8_LAS bf16x8*)(lds + PG8_SA(b, h) + aoff + m * 2048 + k * 1024); } while (0)
#define PG8_LDB(dst, b, h) do { _Pragma("unroll") for (int n = 0; n < 2; ++n) _Pragma("unroll") for (int k = 0; k < 2; ++k) dst[n][k] = *(const PG8_LAS bf16x8*)(lds + PG8_SB(b, h) + boff + n * 2048 + k * 1024); } while (0)
#define PG8_MMA(ai, bj, At, Bt) do { __builtin_amdgcn_s_setprio(1); _Pragma("unroll") for (int m = 0; m < 4; ++m) _Pragma("unroll") for (int n = 0; n < 2; ++n) _Pragma("unroll") for (int k = 0; k < 2; ++k) \
        acc[ai][bj][m][n] = __builtin_amdgcn_mfma_f32_16x16x32_bf16(Bt[n][k], At[m][k], acc[ai][bj][m][n], 0, 0, 0); __builtin_amdgcn_s_setprio(0); } while (0)
#define PG8_WAIT_V(n) asm volatile("s_waitcnt vmcnt(" #n ")" ::: "memory")
#define PG8_WAIT_L(n) asm volatile("s_waitcnt lgkmcnt(" #n ")" ::: "memory")
#define PG8_BAR __builtin_amdgcn_s_barrier()
#define PG8_SCHED __builtin_amdgcn_sched_barrier(0)
    Unit cur, nxt; int ui = 0;
    if (!S.next(0, cur)) return;
    f32x4 acc[2][2][4][2];
#pragma unroll
    for (int a = 0; a < 2; ++a)
#pragma unroll
        for (int b = 0; b < 2; ++b)
#pragma unroll
            for (int m = 0; m < 4; ++m)
#pragma unroll
                for (int n = 0; n < 2; ++n) acc[a][b][m][n] = (f32x4){0.f, 0.f, 0.f, 0.f};
    bf16x8 At[4][2], B0[2][2], B1[2][2];
    const char* cA = (const char*)g.A + (size_t)(cur.pn / g.agc) * g.ags + (size_t)cur.pm * tstepA; const char* cB = (const char*)g.Bt + (size_t)cur.pn * tstepB;
    S.a_ready(cur);
    if constexpr (SP2) {
        PG8_STAGE(PG8_SB(0, 0), cB, voffB); PG8_STAGE(PG8_SB(0, 1), cB + hstepB, voffB); PG8_STAGE(PG8_SA(0, 0), cA, voffA); PG8_STAGE(PG8_SA(0, 1), cA + hstepA, voffA);
        if (wr == 1) PG8_BAR;
        PG8_WAIT_V(2); PG8_BAR;
        PG8_STAGE(PG8_SB(1, 0), cB + kstep, voffB); PG8_STAGE(PG8_SA(1, 0), cA + kstep, voffA); PG8_STAGE(PG8_SB(1, 1), cB + hstepB + kstep, voffB);
        PG8_WAIT_V(6); PG8_BAR;
    } else {
        PG8_STAGE(PG8_SB(0, 0), cB, voffB); PG8_STAGE(PG8_SA(0, 0), cA, voffA); PG8_STAGE(PG8_SB(0, 1), cB + hstepB, voffB); PG8_STAGE(PG8_SA(0, 1), cA + hstepA, voffA);
        if (wr == 1) PG8_BAR;
        PG8_WAIT_V(4); PG8_BAR;
        PG8_STAGE(PG8_SB(1, 0), cB + kstep, voffB); PG8_STAGE(PG8_SA(1, 0), cA + kstep, voffA); PG8_STAGE(PG8_SB(1, 1), cB + hstepB + kstep, voffB);
        PG8_WAIT_V(6); PG8_BAR;
    }
    for (;;) {
        const bool has_next = S.next(ui + 1, nxt);
        const char* nA = has_next ? (const char*)g.A + (size_t)(nxt.pn / g.agc) * g.ags + (size_t)nxt.pm * tstepA : cA; const char* nB = has_next ? (const char*)g.Bt + (size_t)nxt.pn * tstepB : cB;
        for (int t = 0; t < nt; t += 2) {
            const bool last = (t == nt - 2);
            const char* a1 = cA + (size_t)(t + 1) * kstep;
            const char* a2 = last ? nA : cA + (size_t)(t + 2) * kstep; const char* b2 = last ? nB : cB + (size_t)(t + 2) * kstep;
            const char* a3 = a2 + kstep; const char* b3 = b2 + kstep;
            if (last && has_next) S.a_ready(nxt);
            if constexpr (SP2) {
            PG8_LDB(B0, 0, 0); PG8_LDB(B1, 0, 1); PG8_SCHED; PG8_LDA(At, 0, 0); PG8_STAGE(PG8_SA(1, 1), a1 + hstepA, voffA);
            PG8_WAIT_V(8); PG8_WAIT_L(0); PG8_BAR; PG8_MMA(0, 0, At, B0); PG8_MMA(0, 1, At, B1); PG8_BAR; PG8_SCHED;
            PG8_LDA(At, 0, 1); PG8_STAGE(PG8_SB(0, 0), b2, voffB); PG8_STAGE(PG8_SB(0, 1), b2 + hstepB, voffB); PG8_STAGE(PG8_SA(0, 0), a2, voffA);
            PG8_WAIT_V(8); PG8_WAIT_L(0); PG8_BAR; PG8_MMA(1, 0, At, B0); PG8_MMA(1, 1, At, B1); PG8_BAR; PG8_SCHED;
            PG8_LDB(B0, 1, 0); PG8_LDB(B1, 1, 1); PG8_SCHED; PG8_LDA(At, 1, 0); PG8_STAGE(PG8_SA(0, 1), a2 + hstepA, voffA);
            PG8_WAIT_V(8); PG8_WAIT_L(0); PG8_BAR; PG8_MMA(0, 0, At, B0); PG8_MMA(0, 1, At, B1); PG8_BAR; PG8_SCHED;
            PG8_LDA(At, 1, 1); PG8_STAGE(PG8_SB(1, 0), b3, voffB); PG8_STAGE(PG8_SB(1, 1), b3 + hstepB, voffB); PG8_STAGE(PG8_SA(1, 0), a3, voffA);
            PG8_WAIT_V(8); PG8_WAIT_L(0); PG8_BAR; PG8_MMA(1, 0, At, B0); PG8_MMA(1, 1, At, B1); PG8_BAR; PG8_SCHED;
            } else {
            PG8_LDB(B0, 0, 0); PG8_SCHED; PG8_LDA(At, 0, 0); PG8_STAGE(PG8_SA(1, 1), a1 + hstepA, voffA);
            PG8_WAIT_L(8); PG8_BAR; PG8_WAIT_L(0); PG8_MMA(0, 0, At, B0); PG8_BAR; PG8_SCHED;
            PG8_LDB(B1, 0, 1); PG8_STAGE(PG8_SB(0, 0), b2, voffB);
            PG8_BAR; PG8_WAIT_L(0); PG8_MMA(0, 1, At, B1); PG8_BAR;
            PG8_LDA(At, 0, 1); PG8_STAGE(PG8_SA(0, 0), a2, voffA);
            PG8_BAR; PG8_WAIT_L(0); PG8_MMA(1, 0, At, B0); PG8_BAR; PG8_SCHED;
            PG8_STAGE(PG8_SB(0, 1), b2 + hstepB, voffB);
            PG8_WAIT_V(6); PG8_BAR; PG8_MMA(1, 1, At, B1); PG8_BAR;
            PG8_LDB(B0, 1, 0); PG8_SCHED; PG8_LDA(At, 1, 0); PG8_STAGE(PG8_SA(0, 1), a2 + hstepA, voffA);
            PG8_WAIT_L(8); PG8_BAR; PG8_WAIT_L(0); PG8_MMA(0, 0, At, B0); PG8_BAR; PG8_SCHED;
            PG8_LDB(B1, 1, 1); PG8_STAGE(PG8_SB(1, 0), b3, voffB);
            PG8_BAR; PG8_WAIT_L(0); PG8_MMA(0, 1, At, B1); PG8_BAR;
            PG8_LDA(At, 1, 1); PG8_STAGE(PG8_SA(1, 0), a3, voffA);
            PG8_BAR; PG8_WAIT_L(0); PG8_MMA(1, 0, At, B0); PG8_BAR; PG8_SCHED;
            PG8_STAGE(PG8_SB(1, 1), b3 + hstepB, voffB);
            PG8_WAIT_V(6); PG8_BAR; PG8_MMA(1, 1, At, B1); PG8_BAR;
            }
        }
        if constexpr (ALIGN_EPI) { if (wr == 0) PG8_BAR; }
        if constexpr (!Epi::AFTER_DRAIN) { E(acc, cur, wr, wc, fr, fq); S.done(cur); }
        if (!has_next) break;
#pragma unroll
        for (int a = 0; a < 2; ++a)
#pragma unroll
            for (int b = 0; b < 2; ++b)
#pragma unroll
                for (int m = 0; m < 4; ++m)
#pragma unroll
                    for (int n = 0; n < 2; ++n) acc[a][b][m][n] = (f32x4){0.f, 0.f, 0.f, 0.f};
        cur = nxt; cA = nA; cB = nB; ++ui;
        if constexpr (ALIGN_EPI) { if (wr == 1) PG8_BAR; }
    }
    PG8_WAIT_V(0);
    if constexpr (!ALIGN_EPI) { if (wr == 0) PG8_BAR; }
    PG8_BAR;
    if constexpr (Epi::AFTER_DRAIN) { E.fused(acc, cur, wr, wc, fr, fq, lds, wid, lane); S.done(cur); }
#undef PG8_SA
#undef PG8_SB
#undef PG8_STAGE
#undef PG8_LDA
#undef PG8_LDB
#undef PG8_MMA
#undef PG8_WAIT_V
#undef PG8_WAIT_L
#undef PG8_BAR
#undef PG8_SCHED
}
}

#define LAS __attribute__((address_space(3)))
typedef unsigned short u16;
typedef float f32x4 __attribute__((ext_vector_type(4)));
typedef float f32x2 __attribute__((ext_vector_type(2)));
typedef unsigned u32x4 __attribute__((ext_vector_type(4)));
typedef unsigned u32x2 __attribute__((ext_vector_type(2)));
typedef short bf16x8 __attribute__((ext_vector_type(8)));
constexpr int NT = 512;
constexpr int CM = 1024, FF = 2816, TT = 8192, NB = 4, MTOK = NB * TT;
constexpr size_t MiB = 1u << 20;
constexpr size_t WS_WIN = 1 * MiB, WIN_SZ = (size_t)2 * FF * CM * 2;
constexpr size_t WS_WOUT = 45 * MiB, WOUT_SZ = (size_t)CM * FF * 2;
constexpr size_t WS_WRKV = 67 * MiB;
constexpr size_t WS_WL1 = 73 * MiB;
constexpr size_t WS_WL2 = WS_WL1 + 3 * MiB / 2;
constexpr size_t WS_WG2 = WS_WL2 + 1 * MiB;
constexpr size_t WS_WRO = 76 * MiB, WS_WKV = 78 * MiB, WS_WQ = 82 * MiB, WS_WDO = 84 * MiB;
constexpr size_t WS_S0 = 88 * MiB, SLOT = 64 * MiB;
constexpr size_t WS_LORA = WS_S0 + 6 * SLOT;
constexpr size_t WS_END = WS_LORA + 24 * MiB;
constexpr int LDS_BYTES = 159744;
constexpr float LOG2E = 1.4426950408889634f;
constexpr float LAM_INIT1 = 0.35550906759f;

struct Params { const float* in[29]; float* out; unsigned char* ws; };

__device__ __forceinline__ int otid() { int t = threadIdx.x; asm volatile("" : "+v"(t)); return t; }
__device__ __forceinline__ float bf2f(unsigned h) { return __builtin_bit_cast(float, h << 16); }
__device__ __forceinline__ float h2f(unsigned h) { return (float)__builtin_bit_cast(_Float16, (unsigned short)h); }
__device__ __forceinline__ float wave_sum(float v) {
#pragma unroll
    for (int o = 32; o > 0; o >>= 1) v += __shfl_xor(v, o);
    return v;
}
__device__ __forceinline__ float wave_max(float v) {
#pragma unroll
    for (int o = 32; o > 0; o >>= 1) v = fmaxf(v, __shfl_xor(v, o));
    return v;
}
template <int CTRL> __device__ __forceinline__ float dpp_mov(float x) {
    return __builtin_bit_cast(float, __builtin_amdgcn_update_dpp(0, __builtin_bit_cast(int, x), CTRL, 0xF, 0xF, false));
}
__device__ __forceinline__ float sum4(float x) { x += dpp_mov<0xB1>(x); x += dpp_mov<0x4E>(x); return x; }
__device__ __forceinline__ float sum8(float x) { x = sum4(x); x += dpp_mov<0x141>(x); return x; }
__device__ __forceinline__ float sum16(float x) { x = sum8(x); x += dpp_mov<0x140>(x); return x; }
typedef __bf16 bf16x2_t __attribute__((ext_vector_type(2)));
__device__ __forceinline__ unsigned cvt_pk_bf16(float lo, float hi) { const f32x2 v = {lo, hi}; const bf16x2_t b = __builtin_convertvector(v, bf16x2_t); return __builtin_bit_cast(unsigned, b); }
using pg8::pk_f16;

__device__ __forceinline__ void wprep(const float* __restrict__ src, int ld, int col0, int nvalid, int Ks,
                                      u16* __restrict__ dst, int Kd, int nrows, float* tile, int& ctr, const float* __restrict__ gain = nullptr) {
    const int tid = otid(), items_k = Kd >> 7, nitem = (nrows >> 6) * items_k, G = (int)gridDim.x;
    int t0 = ((int)blockIdx.x - ctr) % G; if (t0 < 0) t0 += G;
    for (int t = t0; t < nitem; t += G) {
        const int tn = t / items_k, tk = t - tn * items_k, n0 = tn << 6, k0 = tk << 7;
        const int kr = tid >> 4, c4 = (tid & 15) << 2;
        f32x4 v[4];
#pragma unroll
        for (int i = 0; i < 4; ++i) {
            const int k = k0 + kr + 32 * i;
            v[i] = (f32x4){0.f, 0.f, 0.f, 0.f};
            if (k < Ks && (n0 + c4) < nvalid) { v[i] = *(const f32x4*)(src + (size_t)k * ld + col0 + n0 + c4); if (gain) v[i] = v[i] * gain[k]; }
        }
#pragma unroll
        for (int i = 0; i < 4; ++i) { float* tp = tile + (kr + 32 * i) * 65 + c4; tp[0] = v[i][0]; tp[1] = v[i][1]; tp[2] = v[i][2]; tp[3] = v[i][3]; }
        __syncthreads();
        const int n = tid >> 3, ks = (tid & 7) << 3;
#pragma unroll
        for (int hh = 0; hh < 2; ++hh) {
            const float* tp = tile + (hh * 64 + ks) * 65 + n;
            u32x4 w;
            w.x = cvt_pk_bf16(tp[0], tp[65]); w.y = cvt_pk_bf16(tp[2 * 65], tp[3 * 65]); w.z = cvt_pk_bf16(tp[4 * 65], tp[5 * 65]); w.w = cvt_pk_bf16(tp[6 * 65], tp[7 * 65]);
            *(u32x4*)(dst + (size_t)(n0 + n) * Kd + k0 + hh * 64 + ks) = w;
        }
        __syncthreads();
    }
    ctr += nitem;
}

__device__ __forceinline__ void prep_phase(const Params& p, float* tile) {
    unsigned char* ws = p.ws;
    int ctr = 0;
    for (int mi = 0; mi < 4; ++mi) {
        const float* win = p.in[2] + (size_t)mi * CM * 2 * FF;
        u16* dwin = (u16*)(ws + WS_WIN + mi * WIN_SZ);
        for (int pn = 0; pn < 22; ++pn) {
            wprep(win, 2 * FF, 128 * pn, 128, CM, dwin + (size_t)(256 * pn) * CM, CM, 128, tile, ctr, p.in[1] + mi * CM);
            wprep(win, 2 * FF, FF + 128 * pn, 128, CM, dwin + (size_t)(256 * pn + 128) * CM, CM, 128, tile, ctr, p.in[1] + mi * CM);
        }
        wprep(p.in[3] + (size_t)mi * FF * CM, CM, 0, CM, FF, (u16*)(ws + WS_WOUT + mi * WOUT_SZ), FF, CM, tile, ctr);
    }
    for (int i = 0; i < 3; ++i) wprep(p.in[6] + (size_t)i * CM * CM, CM, 0, CM, CM, (u16*)(ws + WS_WRKV) + (size_t)i * CM * CM, CM, CM, tile, ctr);
    wprep(p.in[8], 64, 0, 64, CM, (u16*)(ws + WS_WL1), CM, 256, tile, ctr);
    wprep(p.in[11], 64, 0, 64, CM, (u16*)(ws + WS_WL1) + (size_t)256 * CM, CM, 256, tile, ctr);
    wprep(p.in[13], 160, 0, 160, CM, (u16*)(ws + WS_WL1) + (size_t)512 * CM, CM, 256, tile, ctr);
    wprep(p.in[9], CM, 0, CM, 64, (u16*)(ws + WS_WL2), 256, CM, tile, ctr);
    wprep(p.in[12], CM, 0, CM, 64, (u16*)(ws + WS_WL2) + (size_t)CM * 256, 256, CM, tile, ctr);
    wprep(p.in[14], CM, 0, CM, 160, (u16*)(ws + WS_WG2), 256, CM, tile, ctr);
    wprep(p.in[20], CM, 0, CM, CM, (u16*)(ws + WS_WRO), CM, CM, tile, ctr);
    wprep(p.in[22], 2 * CM, 0, 2 * CM, CM, (u16*)(ws + WS_WKV), CM, 2 * CM, tile, ctr, p.in[21]);
    wprep(p.in[24], CM, 0, CM, CM, (u16*)(ws + WS_WQ), CM, CM, tile, ctr, p.in[4] + CM);
    wprep(p.in[28], CM, 0, CM, CM, (u16*)(ws + WS_WDO), CM, CM, tile, ctr);
}

__device__ __forceinline__ void cast_phase(const float* __restrict__ X, u16* __restrict__ H, float* __restrict__ rowss) {
    const int tid_ = otid(); const int wave = tid_ >> 6, lane = tid_ & 63;
    for (int row = blockIdx.x * 8 + wave; row < MTOK; row += gridDim.x * 8) {
        const float* xr = X + (size_t)row * CM + lane * 8;
        f32x4 x[4]; float ss = 0.f;
#pragma unroll
        for (int i = 0; i < 4; ++i) { x[i] = *(const f32x4*)(xr + 512 * (i >> 1) + 4 * (i & 1)); ss += x[i][0] * x[i][0] + x[i][1] * x[i][1] + x[i][2] * x[i][2] + x[i][3] * x[i][3]; }
        ss = wave_sum(ss);
        if (lane == 0) rowss[row] = ss;
        u16* hr = H + (size_t)row * CM + lane * 8;
#pragma unroll
        for (int i = 0; i < 2; ++i) { u32x4 w; w.x = cvt_pk_bf16(x[2 * i][0], x[2 * i][1]); w.y = cvt_pk_bf16(x[2 * i][2], x[2 * i][3]); w.z = cvt_pk_bf16(x[2 * i + 1][0], x[2 * i + 1][1]); w.w = cvt_pk_bf16(x[2 * i + 1][2], x[2 * i + 1][3]);
            *(u32x4*)(hr + 512 * i) = w; }
    }
}

__device__ __forceinline__ f32x4 ld_bf16x4(const u16* p) { const u32x2 w = *(const u32x2*)p; return (f32x4){__builtin_bit_cast(float, w.x << 16), __builtin_bit_cast(float, w.x & 0xffff0000u), __builtin_bit_cast(float, w.y << 16), __builtin_bit_cast(float, w.y & 0xffff0000u)}; }
__device__ __forceinline__ void ld_bf16x8(const u16* p, f32x4& lo, f32x4& hi) {
    const u32x4 w = *(const u32x4*)p;
    lo = (f32x4){__builtin_bit_cast(float, w.x << 16), __builtin_bit_cast(float, w.x & 0xffff0000u), __builtin_bit_cast(float, w.y << 16), __builtin_bit_cast(float, w.y & 0xffff0000u)};
    hi = (f32x4){__builtin_bit_cast(float, w.z << 16), __builtin_bit_cast(float, w.z & 0xffff0000u), __builtin_bit_cast(float, w.w << 16), __builtin_bit_cast(float, w.w & 0xffff0000u)};
}
__device__ __forceinline__ void mix_phase(const u16* __restrict__ X, const float* __restrict__ g, const float* __restrict__ mu, u16* __restrict__ o0, size_t ostride) {
    const int tid_ = otid(); const int wave = tid_ >> 6, lane = tid_ & 63;
    f32x4 gg[4], mm[6][4];
#pragma unroll
    for (int i = 0; i < 4; ++i) { const int c = lane * 8 + 512 * (i >> 1) + 4 * (i & 1); gg[i] = *(const f32x4*)(g + c);
#pragma unroll
        for (int j = 0; j < 6; ++j) mm[j][i] = *(const f32x4*)(mu + j * CM + c); }
    for (int row = blockIdx.x * 8 + wave; row < MTOK; row += gridDim.x * 8) {
        const u16* xr = X + (size_t)row * CM + lane * 8;
        const bool first = (row & (TT - 1)) == 0;
        f32x4 x[4], xp[4]; float ss = 0.f, sp = 0.f;
#pragma unroll
        for (int i = 0; i < 2; ++i) {
            ld_bf16x8(xr + 512 * i, x[2 * i], x[2 * i + 1]);
            if (first) { xp[2 * i] = (f32x4){0.f, 0.f, 0.f, 0.f}; xp[2 * i + 1] = (f32x4){0.f, 0.f, 0.f, 0.f}; }
            else ld_bf16x8(xr - CM + 512 * i, xp[2 * i], xp[2 * i + 1]);
        }
#pragma unroll
        for (int i = 0; i < 4; ++i) {
            ss += x[i][0] * x[i][0] + x[i][1] * x[i][1] + x[i][2] * x[i][2] + x[i][3] * x[i][3];
            sp += xp[i][0] * xp[i][0] + xp[i][1] * xp[i][1] + xp[i][2] * xp[i][2] + xp[i][3] * xp[i][3];
        }
        ss = wave_sum(ss); sp = wave_sum(sp);
        const float rstd = rsqrtf(ss * (1.0f / CM) + 1e-6f), rstdp = rsqrtf(sp * (1.0f / CM) + 1e-6f);
        const size_t off = (size_t)row * CM + lane * 8;
        f32x4 h[4], dx[4];
#pragma unroll
        for (int i = 0; i < 4; ++i) { h[i] = x[i] * rstd * gg[i]; dx[i] = xp[i] * rstdp * gg[i] - h[i]; }
#pragma unroll
        for (int j = 0; j < 6; ++j)
#pragma unroll
            for (int i = 0; i < 2; ++i) {
                const f32x4 a = h[2 * i] + dx[2 * i] * mm[j][2 * i], c = h[2 * i + 1] + dx[2 * i + 1] * mm[j][2 * i + 1];
                u32x4 w; w.x = cvt_pk_bf16(a[0], a[1]); w.y = cvt_pk_bf16(a[2], a[3]); w.z = cvt_pk_bf16(c[0], c[1]); w.w = cvt_pk_bf16(c[2], c[3]);
                *(u32x4*)(o0 + j * ostride + off + 512 * i) = w;
            }
    }
}

template <class E> __device__ __forceinline__ void run_gemm(LAS unsigned char* l, const u16* A, int lda, int agc, size_t ags, const u16* Bt, int N, int K, const E& e) {
    pg8::Gemm g{A, Bt, MTOK, N, K, lda, agc, ags};
    pg8::StaticOrder S; S.init(MTOK, N, (int)gridDim.x, (int)blockIdx.x);
    pg8::gemm_phase<E, pg8::StaticOrder, true, true>(l, g, S, e);
}

constexpr int SC_T = 32, SC_BUF = 10752, SC_Y = 21504, SC_YSZ = 512 * 17;
__device__ __forceinline__ void scan_phase(const u16* __restrict__ R, const u16* __restrict__ Kx, const u16* __restrict__ V, const u16* __restrict__ E,
                                           const u16* __restrict__ A, const float* __restrict__ k_k, const float* __restrict__ k_a,
                                           u16* __restrict__ Y, float* sm) {
    const int tid = otid(), wave = tid >> 6, lane = tid & 63;
    const int G = (int)gridDim.x, bid = (int)blockIdx.x;
    for (int ui = bid; ui < 256; ui += G) {
        const int unit = (G == 256) ? ((ui & 7) * 32 + (ui >> 3)) : ui;
        const int bh = unit >> 2, q = unit & 3, b = bh >> 4, h = bh & 15;
        const size_t tok0 = (size_t)b * TT;
        const int nchunk = TT / SC_T;
        __syncthreads();
        if (wave >= 4) {
            const int lt = tid - 256, s = lt >> 3, seg = lt & 7;
            const int s2 = lt >> 1, half = lt & 1;
            float kkw[8], kaw[8];
#pragma unroll
            for (int j = 0; j < 8; ++j) { const int ch = h * 64 + (j >> 2) * 32 + seg * 4 + (j & 3); kkw[j] = k_k[ch]; kaw[j] = k_a[ch]; }
            u32x4 rR, rK, rE, rA, rV = {0u, 0u, 0u, 0u};
#define SC_LD2(P_) ({ const u32x2 lo_ = *(const u32x2*)((P_) + gi), hi_ = *(const u32x2*)((P_) + gi + 32); (u32x4){lo_.x, lo_.y, hi_.x, hi_.y}; })
#define SC_ISSUE(c) do { const size_t gi = (tok0 + (size_t)(c) * SC_T + s) * CM + h * 64 + seg * 4; \
            rR = SC_LD2(R); rK = SC_LD2(Kx); rE = SC_LD2(E); rA = SC_LD2(A); \
            if (lt < 64) rV = *(const u32x4*)(V + (tok0 + (size_t)(c) * SC_T + s2) * CM + h * 64 + 16 * q + half * 8); } while (0)
#define SC_PREP(bufi) do { float* Bf = sm + (bufi) * SC_BUF; \
            float kf[8], af[8], ef[8], rf[8], kkr[8]; \
            _Pragma("unroll") for (int j = 0; j < 4; ++j) { \
                kf[2 * j] = h2f(rK[j] & 0xffffu); kf[2 * j + 1] = h2f(rK[j] >> 16); af[2 * j] = h2f(rA[j] & 0xffffu); af[2 * j + 1] = h2f(rA[j] >> 16); \
                ef[2 * j] = h2f(rE[j] & 0xffffu); ef[2 * j + 1] = h2f(rE[j] >> 16); rf[2 * j] = h2f(rR[j] & 0xffffu); rf[2 * j + 1] = h2f(rR[j] >> 16); } \
            float ssq = 0.f; \
            _Pragma("unroll") for (int j = 0; j < 8; ++j) { kkr[j] = kf[j] * kkw[j]; ssq += kkr[j] * kkr[j]; } \
            ssq = sum8(ssq); const float inv = rsqrtf(fmaxf(ssq, 1e-24f)); \
            f32x4 w0, w1, p0, p1, n0, n1, b0, b1, r0, r1; \
            _Pragma("unroll") for (int j = 0; j < 4; ++j) { \
                const float kA = kkr[j] * inv, kB = kkr[j + 4] * inv; \
                w0[j] = __expf(-ef[j]); w1[j] = __expf(-ef[j + 4]); \
                p0[j] = kf[j] * (1.0f + (af[j] - 1.0f) * kaw[j]); p1[j] = kf[j + 4] * (1.0f + (af[j + 4] - 1.0f) * kaw[j + 4]); \
                n0[j] = kA; n1[j] = kB; b0[j] = kA * af[j]; b1[j] = kB * af[j + 4]; r0[j] = rf[j]; r1[j] = rf[j + 4]; } \
            const int ix = s * 64 + seg * 4; \
            *(f32x4*)(Bf + ix) = w0; *(f32x4*)(Bf + ix + 32) = w1; *(f32x4*)(Bf + 2048 + ix) = p0; *(f32x4*)(Bf + 2048 + ix + 32) = p1; \
            *(f32x4*)(Bf + 4096 + ix) = n0; *(f32x4*)(Bf + 4096 + ix + 32) = n1; *(f32x4*)(Bf + 6144 + ix) = b0; *(f32x4*)(Bf + 6144 + ix + 32) = b1; \
            *(f32x4*)(Bf + 8192 + ix) = r0; *(f32x4*)(Bf + 8192 + ix + 32) = r1; \
            if (lt < 64) { f32x4 v0, v1; \
                _Pragma("unroll") for (int j = 0; j < 2; ++j) { v0[2 * j] = h2f(rV[j] & 0xffffu); v0[2 * j + 1] = h2f(rV[j] >> 16); v1[2 * j] = h2f(rV[j + 2] & 0xffffu); v1[2 * j + 1] = h2f(rV[j + 2] >> 16); } \
                *(f32x4*)(Bf + 10240 + s2 * 16 + half * 8) = v0; *(f32x4*)(Bf + 10240 + s2 * 16 + half * 8 + 4) = v1; } } while (0)
#define SC_YOUT(c) do { const float* ypb = sm + SC_Y + ((c) & 1) * SC_YSZ; \
            _Pragma("unroll") for (int o = 0; o < 2; ++o) { const int oi = lt + 256 * o; const float* qp = ypb + oi * 17; \
                const float a0 = (qp[0] + qp[1]) + (qp[2] + qp[3]), a1 = (qp[4] + qp[5]) + (qp[6] + qp[7]), a2 = (qp[8] + qp[9]) + (qp[10] + qp[11]), a3 = (qp[12] + qp[13]) + (qp[14] + qp[15]); \
                const float yv = (a0 + a1) + (a2 + a3); \
                Y[(tok0 + (size_t)(c) * SC_T + (oi >> 4)) * CM + h * 64 + 16 * q + (oi & 15)] = (u16)(cvt_pk_bf16(yv, yv) & 0xffffu); } } while (0)
            SC_ISSUE(0);
            SC_PREP(0);
            SC_ISSUE(1);
            __syncthreads();
            for (int c = 0; c < nchunk; ++c) {
                if (c > 0) SC_YOUT(c - 1);
                if (c + 1 < nchunk) { SC_PREP((c + 1) & 1); if (c + 2 < nchunk) SC_ISSUE(c + 2); }
                __syncthreads();
            }
            SC_YOUT(nchunk - 1);
#undef SC_ISSUE
#undef SC_LD2
#undef SC_PREP
#undef SC_YOUT
        } else {
            const int c4 = lane & 15, rl = wave * 4 + (lane >> 4);
            f32x2 Sa = {0.f, 0.f}, Sb = {0.f, 0.f};
            __builtin_amdgcn_s_setprio(3);
            __syncthreads();
#define SC_LD(P, s_) do { w##P = *(const f32x4*)(Bo + (s_) * 64); k##P = *(const f32x4*)(Bo + 2048 + (s_) * 64); n##P = *(const f32x4*)(Bo + 4096 + (s_) * 64); \
            b##P = *(const f32x4*)(Bo + 6144 + (s_) * 64); r##P = *(const f32x4*)(Bo + 8192 + (s_) * 64); v##P = Vo[(s_) * 16]; } while (0)
#define SC_STEP(P, s_) do { \
            const f32x2 n01 = {n##P[0], n##P[1]}, n23 = {n##P[2], n##P[3]}, w01 = {w##P[0], w##P[1]}, w23 = {w##P[2], w##P[3]}; \
            const f32x2 k01 = {k##P[0], k##P[1]}, k23 = {k##P[2], k##P[3]}, b01 = {b##P[0], b##P[1]}, b23 = {b##P[2], b##P[3]}; \
            const f32x2 r01 = {r##P[0], r##P[1]}, r23 = {r##P[2], r##P[3]}; \
            f32x2 dd = Sa * n01; dd = Sb * n23 + dd; \
            float d = dd.x + dd.y; d = sum16(d); \
            const f32x2 vv = {v##P, v##P}; \
            f32x2 t0 = vv * k01; t0 = Sa * w01 + t0; f32x2 t1 = vv * k23; t1 = Sb * w23 + t1; \
            const f32x2 d2 = {d, d}; \
            Sa = t0 - d2 * b01; Sb = t1 - d2 * b23; \
            f32x2 yy = Sa * r01; yy = Sb * r23 + yy; \
            yo[(s_) * 272] = yy.x + yy.y; } while (0)
            for (int c = 0; c < nchunk; ++c) {
                const float* Bo = sm + (c & 1) * SC_BUF + c4 * 4;
                const float* Vo = sm + (c & 1) * SC_BUF + 10240 + rl;
                float* yo = sm + SC_Y + (c & 1) * SC_YSZ + rl * 17 + c4;
                f32x4 wA, kA, nA, bA, rA, wB, kB, nB, bB, rB, wC, kC, nC, bC, rC, wD, kD, nD, bD, rD; float vA, vB, vC, vD;
                SC_LD(A, 0); SC_LD(B, 1);
#pragma unroll
                for (int s = 0; s < SC_T; s += 4) {
                    SC_LD(C, s + 2);
                    SC_STEP(A, s);
                    SC_LD(D, s + 3);
                    SC_STEP(B, s + 1);
                    SC_LD(A, (s + 4 < SC_T) ? s + 4 : SC_T - 1);
                    SC_STEP(C, s + 2);
                    SC_LD(B, (s + 5 < SC_T) ? s + 5 : SC_T - 1);
                    SC_STEP(D, s + 3);
                }
                __syncthreads();
            }
#undef SC_LD
#undef SC_STEP
            __builtin_amdgcn_s_setprio(0);
        }
    }
}

struct PostRow { u32x4 yv[2], rv[2], kv[2], vv[2], av[2], gv[2]; };
__device__ __forceinline__ void post_load(PostRow& q, const u16* Y, const u16* R, const u16* Kx, const u16* V, const u16* A, const u16* Gt, size_t off) {
#pragma unroll
    for (int i = 0; i < 2; ++i) { q.yv[i] = *(const u32x4*)(Y + off + 8 * i); q.rv[i] = *(const u32x4*)(R + off + 8 * i); q.kv[i] = *(const u32x4*)(Kx + off + 8 * i);
        q.vv[i] = *(const u32x4*)(V + off + 8 * i); q.av[i] = *(const u32x4*)(A + off + 8 * i); q.gv[i] = *(const u32x4*)(Gt + off + 8 * i); }
}
__device__ __forceinline__ void post_row(const PostRow& q, const float (&lg)[16], const float (&lb)[16], const float (&ka)[16], const float (&rk)[16], u16* Y, size_t off) {
    float y[16], sum = 0.f, bon = 0.f;
#pragma unroll
    for (int j = 0; j < 16; ++j) {
        const unsigned wy = q.yv[j >> 3][(j >> 1) & 3], wr_ = q.rv[j >> 3][(j >> 1) & 3], wk = q.kv[j >> 3][(j >> 1) & 3], wa = q.av[j >> 3][(j >> 1) & 3];
        const unsigned sh = (j & 1) * 16;
        y[j] = bf2f((wy >> sh) & 0xffffu); sum += y[j];
        const float r = h2f((wr_ >> sh) & 0xffffu), k = h2f((wk >> sh) & 0xffffu), a = h2f((wa >> sh) & 0xffffu);
        bon += r * (k * (1.0f + (a - 1.0f) * ka[j])) * rk[j];
    }
    sum = sum4(sum); bon = sum4(bon);
    const float mean = sum * (1.0f / 64.0f);
    float var = 0.f;
#pragma unroll
    for (int j = 0; j < 16; ++j) { const float d = y[j] - mean; var += d * d; }
    var = sum4(var) * (1.0f / 64.0f);
    const float rstd = rsqrtf(var + 64e-5f);
    float o[16];
#pragma unroll
    for (int j = 0; j < 16; ++j) {
        const unsigned wv = q.vv[j >> 3][(j >> 1) & 3], wg = q.gv[j >> 3][(j >> 1) & 3]; const unsigned sh = (j & 1) * 16;
        const float v = h2f((wv >> sh) & 0xffffu), g = bf2f((wg >> sh) & 0xffffu);
        o[j] = ((y[j] - mean) * rstd * lg[j] + lb[j] + bon * v) * g;
    }
#pragma unroll
    for (int i = 0; i < 2; ++i) { u32x4 w; w.x = cvt_pk_bf16(o[8 * i], o[8 * i + 1]); w.y = cvt_pk_bf16(o[8 * i + 2], o[8 * i + 3]); w.z = cvt_pk_bf16(o[8 * i + 4], o[8 * i + 5]); w.w = cvt_pk_bf16(o[8 * i + 6], o[8 * i + 7]);
        *(u32x4*)(Y + off + 8 * i) = w; }
}
__device__ __forceinline__ void post_phase(u16* Y, const u16* __restrict__ R, const u16* __restrict__ Kx, const u16* __restrict__ V,
                                           const u16* __restrict__ A, const u16* __restrict__ Gt, const float* __restrict__ ln_g, const float* __restrict__ ln_b,
                                           const float* __restrict__ k_a, const float* __restrict__ r_k) {
    const int tid_ = otid(); const int wave = tid_ >> 6, lane = tid_ & 63, ch0 = lane * 16;
    float lg[16], lb[16], ka[16], rk[16];
#pragma unroll
    for (int j = 0; j < 16; ++j) { lg[j] = ln_g[ch0 + j]; lb[j] = ln_b[ch0 + j]; ka[j] = k_a[ch0 + j]; rk[j] = r_k[ch0 + j]; }
    const int stride = gridDim.x * 8;
    for (int row = blockIdx.x * 8 + wave; row < MTOK; row += 2 * stride) {
        const size_t off0 = (size_t)row * CM + ch0, off1 = (size_t)(row + stride) * CM + ch0;
        const bool two = (row + stride) < MTOK;
        PostRow q0, q1;
        post_load(q0, Y, R, Kx, V, A, Gt, off0);
        if (two) post_load(q1, Y, R, Kx, V, A, Gt, off1);
        post_row(q0, lg, lb, ka, rk, Y, off0);
        if (two) post_row(q1, lg, lb, ka, rk, Y, off1);
    }
}

__device__ __forceinline__ void headnorm_phase(u16* __restrict__ Hb, const float* __restrict__ gain, float scale) {
    const int tid_ = otid(); const int wave = tid_ >> 6, lane = tid_ & 63, ch0 = lane * 16;
    float gn[16];
#pragma unroll
    for (int j = 0; j < 16; ++j) gn[j] = gain[(ch0 + j) & 63] * scale;
    for (int row = blockIdx.x * 8 + wave; row < MTOK; row += gridDim.x * 8) {
        const size_t off = (size_t)row * CM + ch0;
        u32x4 xv[2]; xv[0] = *(const u32x4*)(Hb + off); xv[1] = *(const u32x4*)(Hb + off + 8);
        float x[16], ss = 0.f;
#pragma unroll
        for (int j = 0; j < 16; ++j) { const unsigned w = xv[j >> 3][(j >> 1) & 3]; x[j] = bf2f((w >> ((j & 1) * 16)) & 0xffffu); ss += x[j] * x[j]; }
        ss = sum4(ss);
        const float r = rsqrtf(ss * (1.0f / 64.0f) + 1e-6f);
#pragma unroll
        for (int i = 0; i < 2; ++i) { u32x4 w; w.x = cvt_pk_bf16(x[8 * i] * r * gn[8 * i], x[8 * i + 1] * r * gn[8 * i + 1]); w.y = cvt_pk_bf16(x[8 * i + 2] * r * gn[8 * i + 2], x[8 * i + 3] * r * gn[8 * i + 3]);
            w.z = cvt_pk_bf16(x[8 * i + 4] * r * gn[8 * i + 4], x[8 * i + 5] * r * gn[8 * i + 5]); w.w = cvt_pk_bf16(x[8 * i + 6] * r * gn[8 * i + 6], x[8 * i + 7] * r * gn[8 * i + 7]);
            *(u32x4*)(Hb + off + 8 * i) = w; }
    }
}

__device__ __forceinline__ void vt_phase(const u16* __restrict__ Vr, u16* __restrict__ VT, u16* ts) {
    const int tid = otid();
    constexpr int PITCH = 66;
    const int nun = NB * 8 * (TT / 64), G = (int)gridDim.x;
    const int tok = tid >> 3, seg = tid & 7;
    u32x4 a = {0u, 0u, 0u, 0u}, c = {0u, 0u, 0u, 0u};
    int unit = blockIdx.x;
    if (unit < nun) { const int tt = unit & 127, h = (unit >> 7) & 7, b = unit >> 10;
        const u16* src = Vr + ((size_t)b * TT + tt * 64 + tok) * CM + h * 128 + seg * 16; a = *(const u32x4*)src; c = *(const u32x4*)(src + 8); }
    for (; unit < nun; unit += G) {
        const int tt = unit & 127, h = (unit >> 7) & 7, b = unit >> 10, t0 = tt * 64;
#pragma unroll
        for (int j = 0; j < 4; ++j) {
            ts[(seg * 16 + 2 * j) * PITCH + tok] = (u16)(a[j] & 0xffffu); ts[(seg * 16 + 2 * j + 1) * PITCH + tok] = (u16)(a[j] >> 16);
            ts[(seg * 16 + 8 + 2 * j) * PITCH + tok] = (u16)(c[j] & 0xffffu); ts[(seg * 16 + 8 + 2 * j + 1) * PITCH + tok] = (u16)(c[j] >> 16);
        }
        __syncthreads();
        const int un = unit + G;
        if (un < nun) { const int tn = un & 127, hn = (un >> 7) & 7, bn = un >> 10;
            const u16* src = Vr + ((size_t)bn * TT + tn * 64 + tok) * CM + hn * 128 + seg * 16; a = *(const u32x4*)src; c = *(const u32x4*)(src + 8); }
        {
            const int d = tid >> 2, sg = tid & 3;
            const unsigned* rowp = (const unsigned*)(ts + d * PITCH + sg * 16);
            u32x4 x, y;
            x.x = rowp[0]; x.y = rowp[1]; x.z = rowp[2]; x.w = rowp[3]; y.x = rowp[4]; y.y = rowp[5]; y.z = rowp[6]; y.w = rowp[7];
            u16* dst = VT + ((((size_t)b * 8 + h) * 128 + tt) * 128 + d) * 64 + sg * 16;
            *(u32x4*)dst = x; *(u32x4*)(dst + 8) = y;
        }
        (void)t0;
        __syncthreads();
    }
}

constexpr int AT_KP = 288, AT_VP = 160, AT_KB = 64 * AT_KP, AT_VB = 128 * AT_VP, AT_BUF = AT_KB + AT_VB;
template <bool DIAG> __device__ __forceinline__ void att_softmax(f32x4 (&st)[4], float& mrow, float& pend, f32x4 (&o)[8], f32x4& lacc, bf16x8 (&pb)[2], int kv0, int quad, int qidx) {
    if (DIAG) {
#pragma unroll
        for (int kb = 0; kb < 4; ++kb)
#pragma unroll
            for (int r = 0; r < 4; ++r) if (kv0 + kb * 16 + quad * 4 + r > qidx) st[kb][r] = -INFINITY;
    }
    float mxa = fmaxf(fmaxf(st[0][0], st[0][1]), st[0][2]), mxb = fmaxf(fmaxf(st[2][0], st[2][1]), st[2][2]);
    mxa = fmaxf(fmaxf(mxa, st[0][3]), st[1][0]); mxb = fmaxf(fmaxf(mxb, st[2][3]), st[3][0]);
    mxa = fmaxf(fmaxf(mxa, st[1][1]), st[1][2]); mxb = fmaxf(fmaxf(mxb, st[3][1]), st[3][2]);
    float mx = fmaxf(fmaxf(mxa, st[1][3]), fmaxf(mxb, st[3][3]));
    float mcmp;
    if (DIAG) { mx = fmaxf(mx, __shfl_xor(mx, 16)); mx = fmaxf(mx, __shfl_xor(mx, 32)); mcmp = mx; }
    else mcmp = pend;
    if (__any(mcmp > mrow)) {
        const float mnew = fmaxf(mrow, mcmp);
        const float alpha = __builtin_amdgcn_exp2f(mrow - mnew);
        mrow = mnew;
#pragma unroll
        for (int db = 0; db < 8; ++db) o[db] = o[db] * alpha;
        lacc = lacc * alpha;
    }
    float ex1 = 0.f;
    if (!DIAG) ex1 = fmaxf(mx, __shfl_xor(mx, 16));
    const f32x2 m2 = {mrow, mrow};
#pragma unroll
    for (int kb = 0; kb < 4; ++kb) {
        const f32x2 d0 = (f32x2){st[kb][0], st[kb][1]} - m2, d1 = (f32x2){st[kb][2], st[kb][3]} - m2;
        st[kb][0] = __builtin_amdgcn_exp2f(d0.x); st[kb][1] = __builtin_amdgcn_exp2f(d0.y); st[kb][2] = __builtin_amdgcn_exp2f(d1.x); st[kb][3] = __builtin_amdgcn_exp2f(d1.y);
    }
#pragma unroll
    for (int kp = 0; kp < 2; ++kp) {
        u32x4 w;
        w.x = cvt_pk_bf16(st[2 * kp][0], st[2 * kp][1]); w.y = cvt_pk_bf16(st[2 * kp][2], st[2 * kp][3]);
        w.z = cvt_pk_bf16(st[2 * kp + 1][0], st[2 * kp + 1][1]); w.w = cvt_pk_bf16(st[2 * kp + 1][2], st[2 * kp + 1][3]);
        pb[kp] = __builtin_bit_cast(bf16x8, w);
    }
    if (!DIAG) pend = fmaxf(ex1, __shfl_xor(ex1, 32)); else pend = mrow;
}
template <bool DIAG> __device__ __forceinline__ void att_tile(const LAS unsigned char* Ks, const LAS unsigned char* Vs, const bf16x8 (&bq)[2][2], f32x4 (&o)[2][8], f32x4 (&lacc)[2], float (&mrow)[2], float (&pend)[2],
                                                          float bbase, float slope2, int kv0, int lr, int quad, int qidx, const bf16x8& ones) {
    f32x4 st[2][4];
#pragma unroll
    for (int kb = 0; kb < 4; ++kb) {
        f32x4 bias;
#pragma unroll
        for (int r = 0; r < 4; ++r) bias[r] = bbase + slope2 * (float)(kb * 16 + r);
#pragma unroll
        for (int c = 0; c < 2; ++c) {
            const LAS unsigned char* kp = Ks + (kb * 16 + lr) * AT_KP + (c * 64 + quad * 8) * 2;
            const bf16x8 a0 = *(const LAS bf16x8*)kp, a1 = *(const LAS bf16x8*)(kp + 64);
            f32x4 z = __builtin_amdgcn_mfma_f32_16x16x32_bf16(a0, bq[c][0], bias, 0, 0, 0);
            st[c][kb] = __builtin_amdgcn_mfma_f32_16x16x32_bf16(a1, bq[c][1], z, 0, 0, 0);
        }
        if (kb == 1) __builtin_amdgcn_sched_barrier(0);
    }
    bf16x8 pb[2][2];
    att_softmax<DIAG>(st[0], mrow[0], pend[0], o[0], lacc[0], pb[0], kv0, quad, qidx);
    att_softmax<DIAG>(st[1], mrow[1], pend[1], o[1], lacc[1], pb[1], kv0, quad, qidx);
#pragma unroll
    for (int kp = 0; kp < 2; ++kp) {
        lacc[0] = __builtin_amdgcn_mfma_f32_16x16x32_bf16(ones, pb[0][kp], lacc[0], 0, 0, 0);
        lacc[1] = __builtin_amdgcn_mfma_f32_16x16x32_bf16(ones, pb[1][kp], lacc[1], 0, 0, 0);
    }
#pragma unroll
    for (int db = 0; db < 8; ++db)
#pragma unroll
        for (int kp = 0; kp < 2; ++kp) {
            const bf16x8 vf = *(const LAS bf16x8*)(Vs + (db * 16 + lr) * AT_VP + (kp * 32 + quad * 8) * 2);
            o[0][db] = __builtin_amdgcn_mfma_f32_16x16x32_bf16(vf, pb[0][kp], o[0][db], 0, 0, 0);
            o[1][db] = __builtin_amdgcn_mfma_f32_16x16x32_bf16(vf, pb[1][kp], o[1][db], 0, 0, 0);
        }
}
__device__ __forceinline__ void attn_phase(const u16* __restrict__ Q, const u16* __restrict__ Kn, const u16* __restrict__ VT, u16* __restrict__ O,
                                           const float* __restrict__ q_norm, const float* __restrict__ k_norm, const float* __restrict__ lam,
                                           const float* __restrict__ subln, unsigned char* sm) {
    const int tid = otid(), wave = tid >> 6, lane = tid & 63, lr = lane & 15, quad = lane >> 4;
    const int G = (int)gridDim.x, bid = (int)blockIdx.x;
    float lam_full, thr;
    {
        const float l0 = lam[lane] * lam[64 + lane], l1 = lam[128 + lane] * lam[192 + lane];
        lam_full = __expf(wave_sum(l0)) - __expf(wave_sum(l1)) + LAM_INIT1;
        const float gq = wave_max(fabsf(q_norm[lane])), gk = wave_max(fabsf(k_norm[lane]));
        thr = 2.0f * (8.0f * gq * gk) + 30.0f;
    }
    const u32x4 onesw = {0x3F803F80u, 0x3F803F80u, 0x3F803F80u, 0x3F803F80u};
    const bf16x8 ones = __builtin_bit_cast(bf16x8, onesw);
    const int nunits = NB * 8 * (TT / 128);
    if (__builtin_amdgcn_readfirstlane(tid) >= 256) __builtin_amdgcn_s_setprio(1);
    for (int rr = 0;; ++rr) {
        const int pos = rr * G + ((rr & 1) ? (G - 1 - bid) : bid);
        if (rr * G >= nunits) break;
        if (pos >= nunits) continue;
        const int b = pos & 3, qt = 63 - ((pos >> 2) & 63), h = 7 - (pos >> 8);
        const int q0 = qt * 128;
        const float slope = __builtin_amdgcn_exp2f(-(float)(h + 1));
        const float slope2 = slope * LOG2E;
        int Wi = (int)(thr / slope) + 1; if (Wi > TT) Wi = TT;
        int kvs = q0 - Wi; if (kvs < 0) kvs = 0; kvs &= ~63;
        const int ntile = (q0 + 128 - kvs) >> 6;
        const size_t tokb = (size_t)b * TT;
        const int qidx = q0 + wave * 16 + lr;
        bf16x8 bq[2][2];
#pragma unroll
        for (int c = 0; c < 2; ++c) {
            u32x4 raw[2]; float qf[16], ss = 0.f;
#pragma unroll
            for (int kk = 0; kk < 2; ++kk) raw[kk] = *(const u32x4*)(Q + (tokb + qidx) * CM + h * 128 + c * 64 + kk * 32 + quad * 8);
#pragma unroll
            for (int j = 0; j < 16; ++j) { const unsigned w = raw[j >> 3][(j >> 1) & 3]; qf[j] = bf2f((w >> ((j & 1) * 16)) & 0xffffu); ss += qf[j] * qf[j]; }
            ss += __shfl_xor(ss, 16); ss += __shfl_xor(ss, 32);
            const float rq = rsqrtf(ss * (1.0f / 64.0f) + 1e-6f) * (0.125f * LOG2E);
#pragma unroll
            for (int kk = 0; kk < 2; ++kk) {
                const f32x4 g0 = *(const f32x4*)(q_norm + kk * 32 + quad * 8), g1 = *(const f32x4*)(q_norm + kk * 32 + quad * 8 + 4);
                u32x4 w;
                w.x = cvt_pk_bf16(qf[8 * kk + 0] * rq * g0[0], qf[8 * kk + 1] * rq * g0[1]); w.y = cvt_pk_bf16(qf[8 * kk + 2] * rq * g0[2], qf[8 * kk + 3] * rq * g0[3]);
                w.z = cvt_pk_bf16(qf[8 * kk + 4] * rq * g1[0], qf[8 * kk + 5] * rq * g1[1]); w.w = cvt_pk_bf16(qf[8 * kk + 6] * rq * g1[2], qf[8 * kk + 7] * rq * g1[3]);
                bq[c][kk] = __builtin_bit_cast(bf16x8, w);
            }
        }
        f32x4 o[2][8], lacc[2];
#pragma unroll
        for (int c = 0; c < 2; ++c) {
            lacc[c] = (f32x4){0.f, 0.f, 0.f, 0.f};
#pragma unroll
            for (int db = 0; db < 8; ++db) o[c][db] = (f32x4){0.f, 0.f, 0.f, 0.f};
        }
        float mrow[2] = {-1e30f, -1e30f}, pend[2] = {-1e30f, -1e30f};
        u32x4 kregA[2], vregA[2], kregB[2], vregB[2];
        const u16* kbase = Kn + ((size_t)b * 8 + h) * 128 * 8192 + tid * 8;
        const u16* vbase = VT + ((size_t)b * 8 + h) * 128 * 8192 + tid * 8;
#define AT_LOAD(P, kv0) do { _Pragma("unroll") for (int i = 0; i < 2; ++i) { \
            kreg##P[i] = *(const u32x4*)(kbase + (size_t)((kv0) >> 6) * 8192 + 4096 * i); \
            vreg##P[i] = *(const u32x4*)(vbase + (size_t)((kv0) >> 6) * 8192 + 4096 * i); } } while (0)
#define AT_STORE(P, bufi) do { unsigned char* bb = sm + (bufi) * AT_BUF; _Pragma("unroll") for (int i = 0; i < 2; ++i) { const int pc = tid + 512 * i; \
            *(u32x4*)(bb + (pc >> 4) * AT_KP + (pc & 15) * 16) = kreg##P[i]; \
            const int sg = pc & 7, k0 = (sg & 3) * 8, ps = (sg >> 2) * 32 + ((k0 & 15) >> 2) * 8 + (k0 >> 4) * 4; \
            unsigned char* vp = bb + AT_KB + (pc >> 3) * AT_VP + ps * 2; \
            *(u32x2*)vp = (u32x2){vreg##P[i].x, vreg##P[i].y}; *(u32x2*)(vp + 16) = (u32x2){vreg##P[i].z, vreg##P[i].w}; } } while (0)
#define AT_COMPUTE(idx_) do { const int kv0 = kvs + (ntile - 1 - (idx_)) * 64; \
            if (kv0 <= q0 + wave * 16 + 15) { const LAS unsigned char* Ks = (const LAS unsigned char*)sm + ((idx_) & 1) * AT_BUF; \
                const float bbase = slope2 * (float)(kv0 + quad * 4 - q0); \
                if (kv0 + 63 > q0 + wave * 16) att_tile<true>(Ks, Ks + AT_KB, bq, o, lacc, mrow, pend, bbase, slope2, kv0, lr, quad, qidx, ones); \
                else att_tile<false>(Ks, Ks + AT_KB, bq, o, lacc, mrow, pend, bbase, slope2, kv0, lr, quad, qidx, ones); } } while (0)
        const int kvtop = kvs + (ntile - 1) * 64;
        __syncthreads();
        AT_LOAD(A, kvtop); AT_STORE(A, 0);
        AT_LOAD(A, kvtop - 64);
        if (ntile > 2) AT_LOAD(B, kvtop - 128);
        __syncthreads();
        for (int idx = 0; idx < ntile; idx += 2) {
            AT_COMPUTE(idx);
            if (idx + 1 < ntile) { AT_STORE(A, 1); if (idx + 3 < ntile) AT_LOAD(A, kvtop - 64 * (idx + 3)); }
            __syncthreads();
            if (idx + 1 < ntile) {
                AT_COMPUTE(idx + 1);
                if (idx + 2 < ntile) { AT_STORE(B, 0); if (idx + 4 < ntile) AT_LOAD(B, kvtop - 64 * (idx + 4)); }
                __syncthreads();
            }
        }
#undef AT_COMPUTE
#undef AT_LOAD
#undef AT_STORE
        const float i0 = 1.0f / lacc[0][0], i1 = lam_full / lacc[1][0];
        float ss = 0.f;
#pragma unroll
        for (int db = 0; db < 8; ++db)
#pragma unroll
            for (int r = 0; r < 4; ++r) { const float v = o[0][db][r] * i0 - o[1][db][r] * i1; o[0][db][r] = v; ss += v * v; }
        ss += __shfl_xor(ss, 16); ss += __shfl_xor(ss, 32);
        const float rn = rsqrtf(ss * (1.0f / 128.0f) + 1e-5f) * (1.0f - LAM_INIT1);
        u16* op = O + (tokb + qidx) * CM + h * 128 + quad * 4;
#pragma unroll
        for (int db = 0; db < 8; ++db) {
            const f32x4 sb = *(const f32x4*)(subln + db * 16 + quad * 4);
            u32x2 w; w.x = cvt_pk_bf16(o[0][db][0] * rn * sb[0], o[0][db][1] * rn * sb[1]); w.y = cvt_pk_bf16(o[0][db][2] * rn * sb[2], o[0][db][3] * rn * sb[3]);
            *(u32x2*)(op + db * 16) = w;
        }
    }
    __builtin_amdgcn_s_setprio(0);
}

#define XB_TMO      128
#define XB_XCNT(j)  (256  + 64 * (j))
#define XB_XSUB(j)  (1280 + 64 * (j))
#define XB_XGEN(j)  (2304 + 64 * (j))
#define XB_TOP      3328
#define XB_TOPGEN   3392
#define XCD_BAR_WORDS 3456
#define XB_SPIN_CAP (1u << 18)
__device__ __forceinline__ unsigned xb_ld(unsigned* p)              { return __hip_atomic_load(p, __ATOMIC_RELAXED, __HIP_MEMORY_SCOPE_AGENT); }
__device__ __forceinline__ unsigned xb_add(unsigned* p, unsigned v) { return __hip_atomic_fetch_add(p, v, __ATOMIC_RELAXED, __HIP_MEMORY_SCOPE_AGENT); }
__device__ __forceinline__ unsigned xb_xcc_id() { return (unsigned)__builtin_amdgcn_s_getreg((3 << 11) | 20) & 0xFu; }
#define XB_SPIN(cond, bar) do { unsigned _sp = 0; while (cond) { __builtin_amdgcn_s_sleep(1); \
    if ((++_sp & 255u) == 0u) { if (xb_ld(&(bar)[XB_TMO])) break; if (_sp > XB_SPIN_CAP) { atomicAdd(&(bar)[XB_TMO], 1u); break; } } } } while (0)
struct XcdBarrier { unsigned* bar; unsigned x; volatile LAS unsigned* st; };
__device__ __forceinline__ XcdBarrier xcd_barrier_post(unsigned* bar, volatile LAS unsigned* st) {
    XcdBarrier b; b.bar = bar; b.x = xb_xcc_id(); b.st = st;
    if (threadIdx.x == 0) (void)xb_add(&bar[XB_XCNT(b.x)], 1u);
    return b;
}
__device__ __forceinline__ void xcd_barrier_complete(unsigned* bar, unsigned x, unsigned& nloc, unsigned& nx) {
    const unsigned G = gridDim.x * gridDim.y * gridDim.z;
    unsigned sum, cnt, mine, sp = 0u;
    for (;;) {
        sum = 0u; cnt = 0u; mine = 0u;
#pragma unroll
        for (unsigned j = 0; j < 16; ++j) { const unsigned c = xb_ld(&bar[XB_XCNT(j)]); sum += c; cnt += (c > 0u) ? 1u : 0u; mine = (j == x) ? c : mine; }
        if (sum == G) break;
        __builtin_amdgcn_s_sleep(1);
        if ((++sp & 255u) == 0u) { if (xb_ld(&bar[XB_TMO])) break; if (sp > XB_SPIN_CAP) { atomicAdd(&bar[XB_TMO], 1u); break; } }
    }
    nloc = mine > 0u ? mine : 1u; nx = cnt > 0u ? cnt : 1u;
}
__device__ __forceinline__ void xcd_barrier(const XcdBarrier& b) {
    asm volatile("s_waitcnt vmcnt(0)" ::: "memory");
    __syncthreads();
    if (threadIdx.x == 0) {
        unsigned* bar = b.bar;
        __builtin_amdgcn_s_waitcnt(0);
        unsigned nloc = b.st[0], nx = b.st[1];
        if (nloc == 0u) { xcd_barrier_complete(bar, b.x, nloc, nx); b.st[0] = nloc; b.st[1] = nx; }
        const unsigned old = xb_add(&bar[XB_XSUB(b.x)], 1u);
        const unsigned gen = old / nloc;
        if (old + 1u == (gen + 1u) * nloc) {
            __builtin_amdgcn_fence(__ATOMIC_RELEASE, "agent");
            asm volatile("s_waitcnt vmcnt(0)" ::: "memory");
            const unsigned og = xb_add(&bar[XB_TOP], 1u);
            const unsigned tg = og / nx;
            if (og + 1u == (tg + 1u) * nx) xb_add(&bar[XB_TOPGEN], 1u);
            else XB_SPIN(xb_ld(&bar[XB_TOPGEN]) == tg, bar);
            __builtin_amdgcn_fence(__ATOMIC_ACQUIRE, "agent");
            xb_add(&bar[XB_XGEN(b.x)], 1u);
            asm volatile("s_waitcnt vmcnt(0)" ::: "memory");
        } else {
            XB_SPIN(xb_ld(&bar[XB_XGEN(b.x)]) == gen, bar);
            __builtin_amdgcn_fence(__ATOMIC_ACQUIRE, "agent");
            asm volatile("s_waitcnt vmcnt(0)" ::: "memory");
        }
    }
    __syncthreads();
}

constexpr size_t WS_BAR = 0;
constexpr size_t WS_RSS = 65536;
constexpr size_t CTL_BYTES = WS_RSS + 5 * (size_t)MTOK * 4;
static_assert(CTL_BYTES <= 1 * MiB, "control region");
constexpr int LDS_ST_OFF = 159488;

__global__ void __launch_bounds__(NT, 2) yoco_fwd(Params p) {
    extern __shared__ __attribute__((aligned(16))) unsigned char lds[];
    cg::grid_group grid = cg::this_grid();
    LAS unsigned char* l3 = (LAS unsigned char*)lds;
    unsigned char* ws = p.ws;
    float* X = p.out;
    u16* S0 = (u16*)(ws + WS_S0); u16* S1 = (u16*)(ws + WS_S0 + SLOT); u16* S2 = (u16*)(ws + WS_S0 + 2 * SLOT);
    u16* S3 = (u16*)(ws + WS_S0 + 3 * SLOT); u16* S4 = (u16*)(ws + WS_S0 + 4 * SLOT); u16* S5 = (u16*)(ws + WS_S0 + 5 * SLOT);
    u16* LORA = (u16*)(ws + WS_LORA);
    float* RSS = (float*)(ws + WS_RSS);
    const size_t SLOT_E = SLOT / 2;
    constexpr int NOGRP = 1 << 20;
    volatile LAS unsigned* st = (volatile LAS unsigned*)(l3 + LDS_ST_OFF);
    if (threadIdx.x < 2) st[threadIdx.x] = 0u;
    __syncthreads();
    const XcdBarrier bar = xcd_barrier_post((unsigned*)(ws + WS_BAR), st);
#define SYNC() xcd_barrier(bar)
#define EPI(MODE, FMT, O_, ldc_, ss_, Xs_, Xd_, rs_, v0_, v1_, rss_, rso_, Xb_) pg8::Epi<pg8::MODE, FMT> e{O_, ldc_, ss_, Xs_, Xd_, rs_, v0_, v1_, rss_, rso_, Xb_, nullptr}
#define EPIR(Xs_, Xsb_, Xd_, Xb_, rs_, rso_) pg8::Epi<pg8::EM_RES, 0> e{nullptr, 0, 0, Xs_, Xd_, rs_, nullptr, nullptr, nullptr, rso_, Xb_, Xsb_}

    prep_phase(p, (float*)lds);
    cast_phase(p.in[0], S3, RSS);
    grid.sync();
    u16* XB = (u16*)p.out;
    { EPI(EM_SWIGLU, 0, S0, FF, 0, nullptr, nullptr, 0.f, nullptr, nullptr, RSS, nullptr, nullptr);
      run_gemm(l3, S3, CM, NOGRP, 0, (const u16*)(ws + WS_WIN), 2 * FF, CM, e); }
    SYNC();
    { EPIR(p.in[0], nullptr, nullptr, XB, 0.5f, nullptr);
      run_gemm(l3, S0, FF, NOGRP, 0, (const u16*)(ws + WS_WOUT), CM, FF, e); }
    SYNC();
    mix_phase(XB, p.in[4], p.in[5], S0, SLOT_E);
    SYNC();
    { EPI(EM_LORA1, 0, LORA, 384, 0, nullptr, nullptr, 0.f, nullptr, nullptr, nullptr, nullptr, nullptr);
      run_gemm(l3, S3, CM, 1, SLOT, (const u16*)(ws + WS_WL1), 768, CM, e); }
    SYNC();
    { EPI(EM_SPLIT, 1, S3, CM, SLOT_E, nullptr, nullptr, 0.f, nullptr, nullptr, nullptr, nullptr, nullptr);
      run_gemm(l3, S0, CM, 4, SLOT, (const u16*)(ws + WS_WRKV), 3 * CM, CM, e); }
    SYNC();
    { EPI(EM_LORA2, 1, S0, CM, SLOT_E, nullptr, nullptr, 0.f, p.in[7], p.in[10], nullptr, nullptr, nullptr);
      run_gemm(l3, LORA, 384, 4, 64 * 2, (const u16*)(ws + WS_WL2), 2 * CM, 256, e); }
    SYNC();
    scan_phase(S3, S4, S5, S0, S1, p.in[15], p.in[16], S2, (float*)lds);
    SYNC();
    { EPI(EM_SPLIT, 0, S0, CM, SLOT_E, nullptr, nullptr, 0.f, nullptr, nullptr, nullptr, nullptr, nullptr);
      run_gemm(l3, LORA + 128, 384, NOGRP, 0, (const u16*)(ws + WS_WG2), CM, 256, e); }
    SYNC();
    post_phase(S2, S3, S4, S5, S1, S0, p.in[18], p.in[19], p.in[16], p.in[17]);
    SYNC();
    { EPIR(nullptr, XB, nullptr, XB, 1.0f, RSS + MTOK);
      run_gemm(l3, S2, CM, NOGRP, 0, (const u16*)(ws + WS_WRO), CM, CM, e); }
    SYNC();
    { EPI(EM_SWIGLU, 0, S0, FF, 0, nullptr, nullptr, 0.f, nullptr, nullptr, RSS + MTOK, nullptr, nullptr);
      run_gemm(l3, XB, CM, NOGRP, 0, (const u16*)(ws + WS_WIN + WIN_SZ), 2 * FF, CM, e); }
    SYNC();
    { EPIR(nullptr, XB, nullptr, XB, 0.5f, RSS + 2 * MTOK);
      run_gemm(l3, S0, FF, NOGRP, 0, (const u16*)(ws + WS_WOUT + WOUT_SZ), CM, FF, e); }
    SYNC();
    { EPI(EM_SWIGLU, 0, S0, FF, 0, nullptr, nullptr, 0.f, nullptr, nullptr, RSS + 2 * MTOK, nullptr, nullptr);
      run_gemm(l3, XB, CM, NOGRP, 0, (const u16*)(ws + WS_WIN + 2 * WIN_SZ), 2 * FF, CM, e); }
    { EPI(EM_KV, 0, S4, CM, SLOT_E, nullptr, nullptr, 0.f, nullptr, nullptr, RSS + 2 * MTOK, nullptr, nullptr);
      run_gemm(l3, XB, CM, NOGRP, 0, (const u16*)(ws + WS_WKV), 2 * CM, CM, e); }
    SYNC();
    headnorm_phase(S4, p.in[23], 1.0f);
    vt_phase(S5, S3, (u16*)lds);
    { EPIR(nullptr, XB, nullptr, XB, 0.5f, RSS + 3 * MTOK);
      run_gemm(l3, S0, FF, NOGRP, 0, (const u16*)(ws + WS_WOUT + 2 * WOUT_SZ), CM, FF, e); }
    SYNC();
    { EPI(EM_SPLIT, 0, S0, CM, SLOT_E, nullptr, nullptr, 0.f, nullptr, nullptr, RSS + 3 * MTOK, nullptr, nullptr);
      run_gemm(l3, XB, CM, NOGRP, 0, (const u16*)(ws + WS_WQ), CM, CM, e); }
    SYNC();
    attn_phase(S0, S4, S3, S1, p.in[25], p.in[23], p.in[26], p.in[27], lds);
    SYNC();
    { EPIR(nullptr, XB, nullptr, S5, 1.0f, RSS + 4 * MTOK);
      run_gemm(l3, S1, CM, NOGRP, 0, (const u16*)(ws + WS_WDO), CM, CM, e); }
    SYNC();
    { EPI(EM_SWIGLU, 0, S0, FF, 0, nullptr, nullptr, 0.f, nullptr, nullptr, RSS + 4 * MTOK, nullptr, nullptr);
      run_gemm(l3, S5, CM, NOGRP, 0, (const u16*)(ws + WS_WIN + 3 * WIN_SZ), 2 * FF, CM, e); }
    SYNC();
    { EPIR(nullptr, S5, X, nullptr, 0.5f, nullptr);
      run_gemm(l3, S0, FF, NOGRP, 0, (const u16*)(ws + WS_WOUT + 3 * WOUT_SZ), CM, FF, e); }
#undef SYNC
#undef EPI
#undef EPIR
}

extern "C" void kernel_launch(void* const* d_in, const int* in_sizes, int n_in, void* d_out, int out_size, void* d_ws, size_t ws_size, hipStream_t stream) {
    static int grid_blocks = 0;
    if (grid_blocks == 0) {
        if (n_in != 29 || out_size != MTOK * CM || ws_size < WS_END) { fprintf(stderr, "kernel_launch: unexpected shapes (n_in %d out %d ws %zu)\n", n_in, out_size, ws_size); grid_blocks = -1; return; }
        int dev = 0, cus = 0, per_cu = 0;
        (void)hipGetDevice(&dev);
        (void)hipDeviceGetAttribute(&cus, hipDeviceAttributeMultiprocessorCount, dev);
        if (hipFuncSetAttribute((const void*)yoco_fwd, hipFuncAttributeMaxDynamicSharedMemorySize, LDS_BYTES) != hipSuccess) { fprintf(stderr, "hipFuncSetAttribute failed\n"); grid_blocks = -1; return; }
        if (hipOccupancyMaxActiveBlocksPerMultiprocessor(&per_cu, (const void*)yoco_fwd, NT, LDS_BYTES) != hipSuccess || per_cu < 1) { fprintf(stderr, "occupancy query failed (%d)\n", per_cu); per_cu = 1; }
        (void)hipGetLastError();
        grid_blocks = cus * per_cu;
        if (grid_blocks > 256) grid_blocks = 256;
    }
    if (grid_blocks < 0) return;
    (void)hipMemsetAsync((char*)d_ws, 0, CTL_BYTES, stream);
    Params p{};
    for (int i = 0; i < 29; ++i) p.in[i] = (const float*)d_in[i];
    p.out = (float*)d_out; p.ws = (unsigned char*)d_ws;
    void* args[] = {&p};
    hipError_t e = hipLaunchCooperativeKernel((const void*)yoco_fwd, dim3(grid_blocks), dim3(NT), args, LDS_BYTES, stream);
    if (e != hipSuccess) fprintf(stderr, "cooperative launch failed: %s (grid %d)\n", hipGetErrorString(e), grid_blocks);
}
```
